# Optimizing an MI355X kernel written in HIP

```python
import jax, jax.numpy as jnp
from jax import lax
import numpy as np

D_MODEL = 1024
BATCH = 2
SEQ = 8192
DEPTH = 1

N_META = 16
D_MIX = D_MODEL
GLA_HEADS = 4
GLA_DK = D_MIX // 4 // GLA_HEADS
GLA_DV = D_MIX // 2 // GLA_HEADS
GLA_RANK = 16
GLA_TAU = 16.0
GLA_CHUNK = 64
GLA_PAD = GLA_CHUNK - N_META
SWA_HEADS = 8
SWA_KV_HEADS = 2
SWA_GROUP = SWA_HEADS // SWA_KV_HEADS
SWA_HD = D_MIX // 2 // SWA_HEADS
SWA_WINDOW = 128
SWA_BLOCK = 128
ROPE_DIM = SWA_HD // 4
ROPE_THETA = 500000.0
D_FF = 4 * D_MODEL
EPS = 1e-5

IN_SIZES = (GLA_HEADS * GLA_DK,
            GLA_HEADS * GLA_DK,
            GLA_HEADS * GLA_DV,
            GLA_HEADS * GLA_DV,
            GLA_RANK,
            SWA_HEADS * SWA_HD,
            SWA_KV_HEADS * SWA_HD,
            SWA_KV_HEADS * SWA_HD)
D_IN = sum(IN_SIZES)

kernel_name = "hybrid_gla_swa_sink_meta_layer"


def rmsnorm(x, w):
    xf = x.astype(jnp.float32)
    y = xf * lax.rsqrt(jnp.mean(jnp.square(xf), axis=-1, keepdims=True) + EPS)
    return (y * w.astype(jnp.float32)).astype(x.dtype)


def partial_rope(x, pos):
    inv_freq = 1.0 / (ROPE_THETA ** (jnp.arange(0, ROPE_DIM, 2, dtype=jnp.float32) / ROPE_DIM))
    ang = pos.astype(jnp.float32)[:, None] * inv_freq[None, :]
    ang = jnp.concatenate([ang, ang], axis=-1)[:, None, :]
    cos, sin = jnp.cos(ang), jnp.sin(ang)
    xr = x[..., :ROPE_DIM].astype(jnp.float32)
    half = ROPE_DIM // 2
    rot = jnp.concatenate([-xr[..., half:], xr[..., :half]], axis=-1)
    xr = (xr * cos + rot * sin).astype(x.dtype)
    return jnp.concatenate([xr, x[..., ROPE_DIM:]], axis=-1)


def gla_chunk_step(S, inp):
    q, k, v, g = inp
    b = jnp.cumsum(g, axis=2)
    causal = jnp.tril(jnp.ones((GLA_CHUNK, GLA_CHUNK), dtype=bool))
    diff = b[:, :, :, None, :] - b[:, :, None, :, :]
    decay = jnp.exp(jnp.where(causal[None, None, :, :, None], diff, -jnp.inf))
    A = jnp.einsum('bhid,bhjd,bhijd->bhij', q, k, decay)
    o = (jnp.einsum('bhij,bhjv->bhiv', A, v)
         + jnp.einsum('bhid,bhdv->bhiv', q * jnp.exp(b), S))
    b_last = b[:, :, -1:, :]
    S = (jnp.exp(b_last[:, :, 0, :])[..., None] * S
         + jnp.einsum('bhjd,bhjv->bhdv', k * jnp.exp(b_last - b), v))
    return S, o


def gla_mixer(q, k, v, r, lr, w_gate_up, b_gate, gla_norm_w):
    B, L, _ = q.shape
    dtype = q.dtype
    g = jax.nn.log_sigmoid((lr @ w_gate_up + b_gate).astype(jnp.float32)) / GLA_TAU
    q = q.astype(jnp.float32).reshape(B, L, GLA_HEADS, GLA_DK) * (GLA_DK ** -0.5)
    k = k.astype(jnp.float32).reshape(B, L, GLA_HEADS, GLA_DK)
    v = v.astype(jnp.float32).reshape(B, L, GLA_HEADS, GLA_DV)
    g = g.reshape(B, L, GLA_HEADS, GLA_DK)
    pad = ((0, 0), (GLA_PAD, 0), (0, 0), (0, 0))
    Lp = L + GLA_PAD
    n_chunks = Lp // GLA_CHUNK

    def to_chunks(t):
        t = jnp.pad(t, pad).reshape(B, n_chunks, GLA_CHUNK, GLA_HEADS, t.shape[-1])
        return t.transpose(1, 0, 3, 2, 4)

    S0 = jnp.zeros((B, GLA_HEADS, GLA_DK, GLA_DV), jnp.float32)
    _, o = lax.scan(gla_chunk_step, S0, (to_chunks(q), to_chunks(k), to_chunks(v), to_chunks(g)))
    o = o.transpose(1, 0, 3, 2, 4).reshape(B, Lp, GLA_HEADS, GLA_DV)[:, GLA_PAD:]
    o = rmsnorm(o.astype(dtype), gla_norm_w)
    o = o * jax.nn.silu(r.reshape(B, L, GLA_HEADS, GLA_DV))
    return o.reshape(B, L, GLA_HEADS * GLA_DV)


def sink_softmax(scores, sink):
    sink_b = jnp.broadcast_to(sink, scores.shape[:-1] + (1,))
    p = jax.nn.softmax(jnp.concatenate([scores, sink_b], axis=-1), axis=-1)
    return p[..., :-1]


def swa_mixer(q, k, v, sinks, pos):
    B, L, _ = q.shape
    dtype = q.dtype
    q = partial_rope(q.reshape(B, L, SWA_HEADS, SWA_HD), pos) * (SWA_HD ** -0.5)
    k = partial_rope(k.reshape(B, L, SWA_KV_HEADS, SWA_HD), pos)
    v = v.reshape(B, L, SWA_KV_HEADS, SWA_HD)
    q = q.reshape(B, L, SWA_KV_HEADS, SWA_GROUP, SWA_HD)
    qm, qr = q[:, :N_META], q[:, N_META:]
    km, kr = k[:, :N_META], k[:, N_META:]
    vm, vr = v[:, :N_META], v[:, N_META:]
    sink = sinks.astype(jnp.float32).reshape(SWA_KV_HEADS, SWA_GROUP)

    sm = jnp.einsum('bqkgd,bjkd->bkgqj', qm, km).astype(jnp.float32)
    mmask = jnp.tril(jnp.ones((N_META, N_META), dtype=bool))
    pm = sink_softmax(jnp.where(mmask, sm, -jnp.inf), sink[None, :, :, None, None])
    om = jnp.einsum('bkgqj,bjkd->bqkgd', pm.astype(dtype), vm).reshape(B, N_META, SWA_HEADS * SWA_HD)

    S = L - N_META
    nb = S // SWA_BLOCK
    qb = qr.reshape(B, nb, SWA_BLOCK, SWA_KV_HEADS, SWA_GROUP, SWA_HD)

    def band(t):
        cur = t.reshape(B, nb, SWA_BLOCK, SWA_KV_HEADS, SWA_HD)
        prev = jnp.pad(t, ((0, 0), (SWA_BLOCK, 0), (0, 0), (0, 0)))[:, :S]
        prev = prev.reshape(B, nb, SWA_BLOCK, SWA_KV_HEADS, SWA_HD)
        return jnp.concatenate([prev, cur], axis=2)

    kw, vw = band(kr), band(vr)
    s_meta = jnp.einsum('bnqkgd,bjkd->bnkgqj', qb, km).astype(jnp.float32)
    s_win = jnp.einsum('bnqkgd,bnjkd->bnkgqj', qb, kw).astype(jnp.float32)
    rr = jnp.arange(SWA_BLOCK)[:, None]
    jj = jnp.arange(2 * SWA_BLOCK)[None, :]
    dist = SWA_BLOCK + rr - jj
    in_band = (dist >= 0) & (dist < SWA_WINDOW)
    blk = jnp.arange(nb)[:, None, None]
    wmask = in_band[None] & ((blk > 0) | (jj[None] >= SWA_BLOCK))
    s_win = jnp.where(wmask[None, :, None, None], s_win, -jnp.inf)
    p = sink_softmax(jnp.concatenate([s_meta, s_win], axis=-1),
                     sink[None, None, :, :, None, None]).astype(dtype)
    orr = (jnp.einsum('bnkgqj,bjkd->bnqkgd', p[..., :N_META], vm)
           + jnp.einsum('bnkgqj,bnjkd->bnqkgd', p[..., N_META:], vw))
    orr = orr.reshape(B, S, SWA_HEADS * SWA_HD)
    return jnp.concatenate([om, orr], axis=1)


def hybrid_layer(h, pos, norm_mix_w, w_in, w_gate_up, b_gate, gla_norm_w, sinks,
                 w_out, norm_ff_w, w_ff1, w_ff2):
    u = rmsnorm(h, norm_mix_w)
    proj = u @ w_in
    split_points = np.cumsum(IN_SIZES)[:-1].tolist()
    gq, gk, gv, gr, glr, sq, sk, sv = jnp.split(proj, split_points, axis=-1)
    o_gla = gla_mixer(gq, gk, gv, gr, glr, w_gate_up, b_gate, gla_norm_w)
    o_swa = swa_mixer(sq, sk, sv, sinks, pos)
    h = h + jnp.concatenate([o_gla, o_swa], axis=-1) @ w_out
    f = rmsnorm(h, norm_ff_w)
    return h + jnp.square(jax.nn.relu(f @ w_ff1)) @ w_ff2


def setup_inputs(seed: int = 0) -> dict:
    key = jax.random.key(seed)
    ks = jax.random.split(key, 14)
    f32 = jnp.float32
    nrm = lambda k, shape, s: jax.random.normal(k, shape, f32) * s
    return {
        "x": nrm(ks[0], (BATCH, SEQ, D_MODEL), 1.0),
        "meta_tokens": nrm(ks[1], (N_META, D_MODEL), 1.0),
        "norm_mix_w": 1.0 + nrm(ks[2], (DEPTH, D_MODEL), 0.02),
        "w_in": nrm(ks[3], (DEPTH, D_MODEL, D_IN), D_MODEL ** -0.5),
        "w_gate_up": nrm(ks[4], (DEPTH, GLA_RANK, GLA_HEADS * GLA_DK), GLA_RANK ** -0.5),
        "b_gate": nrm(ks[5], (DEPTH, GLA_HEADS * GLA_DK), 0.1),
        "gla_norm_w": 1.0 + nrm(ks[6], (DEPTH, GLA_DV), 0.02),
        "sinks": nrm(ks[7], (DEPTH, SWA_HEADS), 1.0),
        "w_out": nrm(ks[8], (DEPTH, D_MIX, D_MODEL), D_MIX ** -0.5),
        "norm_ff_w": 1.0 + nrm(ks[9], (DEPTH, D_MODEL), 0.02),
        "w_ff1": nrm(ks[10], (DEPTH, D_MODEL, D_FF), D_MODEL ** -0.5),
        "w_ff2": nrm(ks[11], (DEPTH, D_FF, D_MODEL), D_FF ** -0.5),
        "final_norm_w": 1.0 + nrm(ks[12], (D_MODEL,), 0.02),
    }


def reference(x, meta_tokens, norm_mix_w, w_in, w_gate_up, b_gate, gla_norm_w, sinks,
              w_out, norm_ff_w, w_ff1, w_ff2, final_norm_w):
    B = x.shape[0]
    meta = jnp.broadcast_to(meta_tokens[None].astype(x.dtype), (B, N_META, D_MODEL))
    h = jnp.concatenate([meta, x], axis=1)
    pos = jnp.arange(h.shape[1], dtype=jnp.int32)
    for layer in range(DEPTH):
        h = hybrid_layer(h, pos, norm_mix_w[layer], w_in[layer], w_gate_up[layer], b_gate[layer],
                         gla_norm_w[layer], sinks[layer], w_out[layer], norm_ff_w[layer],
                         w_ff1[layer], w_ff2[layer])
    return rmsnorm(h, final_norm_w)[:, N_META:]
```

```cpp
#include <hip/hip_runtime.h>
#include <hip/hip_cooperative_groups.h>
#include <cstdio>
#include <cstdint>
namespace cg = cooperative_groups;
namespace pg8 {
#define PG8_LAS __attribute__((address_space(3)))
typedef unsigned short bf16_t;
typedef short bf16x8 __attribute__((ext_vector_type(8)));
typedef float f32x4 __attribute__((ext_vector_type(4)));
typedef unsigned u32x4 __attribute__((ext_vector_type(4)));
constexpr int BM = 256, BK = 64, HALF = 128, HTB = HALF * BK * 2  , STAGE_BYTES = 8 * HTB, NXCD = 8, WGM = 8;

__host__ __device__ __forceinline__ int lds_byte(int r, int c) { const int st = (r >> 4) * 2 + (c >> 5), rr = r & 15, cc = c & 31, ob = rr * 64 + cc * 2; return st * 1024 + (ob ^ (((ob >> 9) & 1) << 5)); }
__host__ __device__ __forceinline__ void stage_rc(int b, int& R, int& C) { const int st = b / 1024, sb = b % 1024, swz = sb ^ (((sb >> 9) & 1) << 5); R = (st >> 1) * 16 + swz / 64; C = (st & 1) * 32 + (swz % 64) / 2; }
__host__ __device__ __forceinline__ int perm32(int rho) { const int n = rho >> 4, i = rho & 15; return 8 * (i >> 2) + 4 * n + (i & 3); }

struct Unit { int pm, pn; };
struct Gemm { const bf16_t* A; const bf16_t* Bt; int M, N, K; };

struct StaticOrder {
    int nM, nN, nwg, G, c;
    __host__ __device__ void init(int M, int N, int G_, int c_) { nM = M / BM; nN = N / BM; nwg = nM * nN; G = G_; c = c_; }
    __host__ __device__ bool next(int i, Unit& u) const {
        const long L = (long)i * G + c; if (L >= nwg) return false;
        int wgid = (int)L; { const int q = nwg / NXCD, r = nwg % NXCD, xcd = wgid % NXCD, off = wgid / NXCD; wgid = (xcd < r ? xcd * (q + 1) : r * (q + 1) + (xcd - r) * q) + off; }
        const int nig = WGM * nN, gid = wgid / nig, fm = gid * WGM, gsz = (nM - fm) < WGM ? (nM - fm) : WGM;
        u.pm = fm + ((wgid % nig) % gsz); u.pn = (wgid % nig) / gsz; return true;
    }
    __device__ __forceinline__ void a_ready(const Unit&) const {}
    __device__ __forceinline__ void done(const Unit&) const {}
};

__device__ __forceinline__ unsigned cvt_pk_bf16(float lo, float hi) { unsigned r; asm volatile("v_cvt_pk_bf16_f32 %0, %1, %2" : "=v"(r) : "v"(lo), "v"(hi)); return r; }
typedef float f32x2 __attribute__((ext_vector_type(2)));
template <class Epi, class Sched, bool ALIGN_EPI = false, bool SP2 = false>
__device__ __forceinline__ void gemm_phase(PG8_LAS unsigned char* lds, const Gemm g, const Sched& S, const Epi& E) {
    const int tid = threadIdx.x, wid = __builtin_amdgcn_readfirstlane(tid >> 6), lane = tid & 63, wr = wid >> 2, wc = wid & 3, fr = lane & 15, fq = lane >> 4;
    const int K = g.K, nt = K / BK;
    unsigned voffA[2], voffB[2];
#pragma unroll
    for (int i = 0; i < 2; ++i) { int R, C; stage_rc(tid * 16 + i * 8192, R, C); const int Rb = Epi::PERM ? ((R & ~31) + perm32(R & 31)) : R;
        voffA[i] = (unsigned)(R * K + C) * 2u; voffB[i] = (unsigned)(Rb * K + C) * 2u; }
    const size_t kstep = (size_t)(BK * 2);
    const size_t hstep = (size_t)HALF * K * 2;
    const size_t tstep = 2 * hstep;
    const unsigned ldsw = (unsigned)wid * 1024u;
    const int aoff = lds_byte(wr * 64 + fr, fq * 8), boff = lds_byte(wc * 32 + fr, fq * 8);
#define PG8_SA(b, h) (((b) * 2 + (h)) * HTB)
#define PG8_SB(b, h) ((4 + (b) * 2 + (h)) * HTB)
#define PG8_STAGE(bufoff, gbase, voff) do { _Pragma("unroll") for (int _i = 0; _i < 2; ++_i) \
        __builtin_amdgcn_global_load_lds((const unsigned*)((const char*)(gbase) + (voff)[_i]), (PG8_LAS unsigned*)(lds + (bufoff) + ldsw + _i * 8192), 16, 0, 0); } while (0)
#define PG8_LDA(dst, b, h) do { _Pragma("unroll") for (int m = 0; m < 4; ++m) _Pragma("unroll") for (int k = 0; k < 2; ++k) dst[m][k] = *(const PG8_LAS bf16x8*)(lds + PG8_SA(b, h) + aoff + m * 2048 + k * 1024); } while (0)
#define PG8_LDB(dst, b, h) do { _Pragma("unroll") for (int n = 0; n < 2; ++n) _Pragma("unroll") for (int k = 0; k < 2; ++k) dst[n][k] = *(const PG8_LAS bf16x8*)(lds + PG8_SB(b, h) + boff + n * 2048 + k * 1024); } while (0)
#define PG8_MMA(ai, bj, At, Bt) do { __builtin_amdgcn_s_setprio(1); _Pragma("unroll") for (int m = 0; m < 4; ++m) _Pragma("unroll") for (int n = 0; n < 2; ++n) _Pragma("unroll") for (int k = 0; k < 2; ++k) \
        acc[ai][bj][m][n] = __builtin_amdgcn_mfma_f32_16x16x32_bf16(Bt[n][k], At[m][k], acc[ai][bj][m][n], 0, 0, 0); __builtin_amdgcn_s_setprio(0); } while (0)
#define PG8_WAIT_V(n) asm volatile("s_waitcnt vmcnt(" #n ")" ::: "memory")
#define PG8_WAIT_L(n) asm volatile("s_waitcnt lgkmcnt(" #n ")" ::: "memory")
#define PG8_BAR __builtin_amdgcn_s_barrier()
#define PG8_SCHED __builtin_amdgcn_sched_barrier(0)
    Unit cur, nxt; int ui = 0;
    if (!S.next(0, cur)) return;
    f32x4 acc[2][2][4][2];
#pragma unroll
    for (int a = 0; a < 2; ++a)
#pragma unroll
        for (int b = 0; b < 2; ++b)
#pragma unroll
            for (int m = 0; m < 4; ++m)
#pragma unroll
                for (int n = 0; n < 2; ++n) acc[a][b][m][n] = (f32x4){0.f, 0.f, 0.f, 0.f};
    bf16x8 At[4][2], B0[2][2], B1[2][2];
    const char* cA = (const char*)g.A + (size_t)cur.pm * tstep; const char* cB = (const char*)g.Bt + (size_t)cur.pn * tstep;
    S.a_ready(cur);
    if constexpr (SP2) {
        PG8_STAGE(PG8_SB(0, 0), cB, voffB); PG8_STAGE(PG8_SB(0, 1), cB + hstep, voffB); PG8_STAGE(PG8_SA(0, 0), cA, voffA); PG8_STAGE(PG8_SA(0, 1), cA + hstep, voffA);
        if (wr == 1) PG8_BAR;
        PG8_WAIT_V(2); PG8_BAR;
        PG8_STAGE(PG8_SB(1, 0), cB + kstep, voffB); PG8_STAGE(PG8_SA(1, 0), cA + kstep, voffA); PG8_STAGE(PG8_SB(1, 1), cB + hstep + kstep, voffB);
        PG8_WAIT_V(6); PG8_BAR;
    } else {
        PG8_STAGE(PG8_SB(0, 0), cB, voffB); PG8_STAGE(PG8_SA(0, 0), cA, voffA); PG8_STAGE(PG8_SB(0, 1), cB + hstep, voffB); PG8_STAGE(PG8_SA(0, 1), cA + hstep, voffA);
        if (wr == 1) PG8_BAR;
        PG8_WAIT_V(4); PG8_BAR;
        PG8_STAGE(PG8_SB(1, 0), cB + kstep, voffB); PG8_STAGE(PG8_SA(1, 0), cA + kstep, voffA); PG8_STAGE(PG8_SB(1, 1), cB + hstep + kstep, voffB);
        PG8_WAIT_V(6); PG8_BAR;
    }
    for (;;) {
        const bool has_next = S.next(ui + 1, nxt);
        const char* nA = has_next ? (const char*)g.A + (size_t)nxt.pm * tstep : cA; const char* nB = has_next ? (const char*)g.Bt + (size_t)nxt.pn * tstep : cB;
        for (int t = 0; t < nt; t += 2) {
            const bool last = (t == nt - 2);
            const char* a1 = cA + (size_t)(t + 1) * kstep;
            const char* a2 = last ? nA : cA + (size_t)(t + 2) * kstep; const char* b2 = last ? nB : cB + (size_t)(t + 2) * kstep;
            const char* a3 = a2 + kstep; const char* b3 = b2 + kstep;
            if (last && has_next) S.a_ready(nxt);
            if constexpr (SP2) {
            PG8_LDB(B0, 0, 0); PG8_LDB(B1, 0, 1); PG8_SCHED; PG8_LDA(At, 0, 0); PG8_STAGE(PG8_SA(1, 1), a1 + hstep, voffA);
            PG8_WAIT_V(8); PG8_WAIT_L(0); PG8_BAR; PG8_MMA(0, 0, At, B0); PG8_MMA(0, 1, At, B1); PG8_BAR; PG8_SCHED;
            PG8_LDA(At, 0, 1); PG8_STAGE(PG8_SB(0, 0), b2, voffB); PG8_STAGE(PG8_SB(0, 1), b2 + hstep, voffB); PG8_STAGE(PG8_SA(0, 0), a2, voffA);
            PG8_WAIT_V(8); PG8_WAIT_L(0); PG8_BAR; PG8_MMA(1, 0, At, B0); PG8_MMA(1, 1, At, B1); PG8_BAR; PG8_SCHED;
            PG8_LDB(B0, 1, 0); PG8_LDB(B1, 1, 1); PG8_SCHED; PG8_LDA(At, 1, 0); PG8_STAGE(PG8_SA(0, 1), a2 + hstep, voffA);
            PG8_WAIT_V(8); PG8_WAIT_L(0); PG8_BAR; PG8_MMA(0, 0, At, B0); PG8_MMA(0, 1, At, B1); PG8_BAR; PG8_SCHED;
            PG8_LDA(At, 1, 1); PG8_STAGE(PG8_SB(1, 0), b3, voffB); PG8_STAGE(PG8_SB(1, 1), b3 + hstep, voffB); PG8_STAGE(PG8_SA(1, 0), a3, voffA);
            PG8_WAIT_V(8); PG8_WAIT_L(0); PG8_BAR; PG8_MMA(1, 0, At, B0); PG8_MMA(1, 1, At, B1); PG8_BAR; PG8_SCHED;
            } else {
            PG8_LDB(B0, 0, 0); PG8_SCHED; PG8_LDA(At, 0, 0); PG8_STAGE(PG8_SA(1, 1), a1 + hstep, voffA);
            PG8_WAIT_L(8); PG8_BAR; PG8_WAIT_L(0); PG8_MMA(0, 0, At, B0); PG8_BAR; PG8_SCHED;
            PG8_LDB(B1, 0, 1); PG8_STAGE(PG8_SB(0, 0), b2, voffB);
            PG8_BAR; PG8_WAIT_L(0); PG8_MMA(0, 1, At, B1); PG8_BAR;
            PG8_LDA(At, 0, 1); PG8_STAGE(PG8_SA(0, 0), a2, voffA);
            PG8_BAR; PG8_WAIT_L(0); PG8_MMA(1, 0, At, B0); PG8_BAR; PG8_SCHED;
            PG8_STAGE(PG8_SB(0, 1), b2 + hstep, voffB);
            PG8_WAIT_V(6); PG8_BAR; PG8_MMA(1, 1, At, B1); PG8_BAR;
            PG8_LDB(B0, 1, 0); PG8_SCHED; PG8_LDA(At, 1, 0); PG8_STAGE(PG8_SA(0, 1), a2 + hstep, voffA);
            PG8_WAIT_L(8); PG8_BAR; PG8_WAIT_L(0); PG8_MMA(0, 0, At, B0); PG8_BAR; PG8_SCHED;
            PG8_LDB(B1, 1, 1); PG8_STAGE(PG8_SB(1, 0), b3, voffB);
            PG8_BAR; PG8_WAIT_L(0); PG8_MMA(0, 1, At, B1); PG8_BAR;
            PG8_LDA(At, 1, 1); PG8_STAGE(PG8_SA(1, 0), a3, voffA);
            PG8_BAR; PG8_WAIT_L(0); PG8_MMA(1, 0, At, B0); PG8_BAR; PG8_SCHED;
            PG8_STAGE(PG8_SB(1, 1), b3 + hstep, voffB);
            PG8_WAIT_V(6); PG8_BAR; PG8_MMA(1, 1, At, B1); PG8_BAR;
            }
        }
        if constexpr (ALIGN_EPI) { if (wr == 0) PG8_BAR; }
        if constexpr (!Epi::AFTER_DRAIN) { E(acc, cur, wr, wc, fr, fq); S.done(cur); }
        if (!has_next) break;
#pragma unroll
        for (int a = 0; a < 2; ++a)
#pragma unroll
            for (int b = 0; b < 2; ++b)
#pragma unroll
                for (int m = 0; m < 4; ++m)
#pragma unroll
                    for (int n = 0; n < 2; ++n) acc[a][b][m][n] = (f32x4){0.f, 0.f, 0.f, 0.f};
        cur = nxt; cA = nA; cB = nB; ++ui;
        if constexpr (ALIGN_EPI) { if (wr == 1) PG8_BAR; }
    }
    PG8_WAIT_V(0);
    if constexpr (!ALIGN_EPI) { if (wr == 0) PG8_BAR; }
    PG8_BAR;
    if constexpr (Epi::AFTER_DRAIN) { E.fused(acc, cur, wr, wc, fr, fq, lds, wid, lane); S.done(cur); }
#undef PG8_SA
#undef PG8_SB
#undef PG8_STAGE
#undef PG8_LDA
#undef PG8_LDB
#undef PG8_MMA
#undef PG8_WAIT_V
#undef PG8_WAIT_L
#undef PG8_BAR
#undef PG8_SCHED
}
}

#ifndef MK_MULTI
#define MK_MULTI 0
#endif
constexpr int T = 8192, NBATCH = 2, M = NBATCH * T, D = 1024, FF = 4096, DIN = 2320, NIN = 2560, LDP = 2304, NMETA = 16, PMW = 1040;
constexpr int GQ = 0, GK = 256, GV = 512, GR = 1024, SQ = 1536, SK = 2048, SV = 2176;
constexpr float EPS = 1e-5f, LOG2E = 1.4426950408889634f;
constexpr size_t MiB = 1u << 20;
constexpr size_t WS_SSQ2 = 0, WS_SSQ3 = 65536, WS_PM = 131072, WS_ROPE = 262144;
constexpr size_t WS_WIN = 1 * MiB, WS_WO = 6 * MiB, WS_W1 = 8 * MiB, WS_W2 = 16 * MiB, WS_DC = 24 * MiB;
constexpr size_t WS_XN = 26 * MiB, WS_PROJ = 58 * MiB, WS_G = 130 * MiB, WS_DST = 146 * MiB, WS_ACT = 58 * MiB, WS_ST = 186 * MiB, WS_MIX = 202 * MiB, WS_END = 234 * MiB;
constexpr int LDS_BYTES = 131072;

typedef unsigned short bf16;
typedef short bf16x8 __attribute__((ext_vector_type(8)));
typedef float f32x4 __attribute__((ext_vector_type(4)));
typedef unsigned u32x4 __attribute__((ext_vector_type(4)));
typedef unsigned u32x2 __attribute__((ext_vector_type(2)));
using pg8::cvt_pk_bf16;

__device__ __forceinline__ float bf2f(unsigned short b) { return __uint_as_float((unsigned)b << 16); }
__device__ __forceinline__ float fexp(float x) { return __builtin_amdgcn_exp2f(x * LOG2E); }
__device__ __forceinline__ float wave_sum(float v) {
#pragma unroll
    for (int o = 1; o < 64; o <<= 1) v += __shfl_xor(v, o);
    return v;
}
__device__ __forceinline__ float logsig(float v) {
    const float e = __builtin_amdgcn_exp2f(-fabsf(v) * LOG2E);
    return fminf(v, 0.f) - __builtin_amdgcn_logf(1.f + e) * 0.6931471805599453f;
}
__device__ __forceinline__ u32x4 pack8(f32x4 a, f32x4 b) { u32x4 w; w.x = cvt_pk_bf16(a[0], a[1]); w.y = cvt_pk_bf16(a[2], a[3]); w.z = cvt_pk_bf16(b[0], b[1]); w.w = cvt_pk_bf16(b[2], b[3]); return w; }

struct Args { const float* in[13]; float* out; unsigned char* ws; int ph_lo, ph_hi; };

namespace pg8 {
struct EpiIn {
    static constexpr bool PERM = true, AFTER_DRAIN = false;
    bf16_t* P; float* G; const float* bgate; const float* rope;
    __device__ __forceinline__ void operator()(const f32x4 (&acc)[2][2][4][2], const Unit& u, int wr, int wc, int fr, int fq) const {
        const int row0 = u.pm * BM + wr * 64 + fr, pn = u.pn;
        if (pn == 9) {
            const int col0 = wc * 32 + 8 * fq;
            f32x4 bv[2][2];
#pragma unroll
            for (int bj = 0; bj < 2; ++bj)
#pragma unroll
                for (int n = 0; n < 2; ++n) bv[bj][n] = *(const f32x4*)(bgate + col0 + bj * HALF + 4 * n);
#pragma unroll
            for (int ai = 0; ai < 2; ++ai)
#pragma unroll
                for (int m = 0; m < 4; ++m) { float* rowp = G + (size_t)(row0 + ai * HALF + m * 16) * 256 + col0;
#pragma unroll
                    for (int bj = 0; bj < 2; ++bj)
#pragma unroll
                        for (int n = 0; n < 2; ++n) { f32x4 v = acc[ai][bj][m][n] + bv[bj][n]; f32x4 g;
#pragma unroll
                            for (int e = 0; e < 4; ++e) g[e] = logsig(v[e]) * 0.0625f;
                            *(f32x4*)(rowp + bj * HALF + 4 * n) = g; } }
        } else {
            const bool rope_tile = (pn >= 6) && ((wc & 1) == 0);
            const float sc = (pn == 0 || pn == 6 || pn == 7) ? 0.125f : 1.f;
            const int col0 = pn * BM + wc * 32 + 8 * fq;
            const float sgn = (fq == 0) ? -1.f : 1.f; const bool app = fq < 2;
#pragma unroll
            for (int ai = 0; ai < 2; ++ai)
#pragma unroll
                for (int m = 0; m < 4; ++m) { const int row = row0 + ai * HALF + m * 16; bf16_t* rowp = P + (size_t)row * 2304 + col0;
                    f32x4 c0 = {1.f, 1.f, 1.f, 1.f}, c1 = c0, s0 = {0.f, 0.f, 0.f, 0.f}, s1 = s0;
                    if (rope_tile) { const float* rp = rope + (size_t)(16 + (row & 8191)) * 16; c0 = *(const f32x4*)rp; c1 = *(const f32x4*)(rp + 4); s0 = *(const f32x4*)(rp + 8); s1 = *(const f32x4*)(rp + 12); }
#pragma unroll
                    for (int bj = 0; bj < 2; ++bj) { f32x4 v0 = acc[ai][bj][m][0], v1 = acc[ai][bj][m][1];
                        if (rope_tile && (pn != 8 || bj == 0)) {
                            f32x4 p0, p1;
#pragma unroll
                            for (int e = 0; e < 4; ++e) { p0[e] = __shfl_xor(v0[e], 16); p1[e] = __shfl_xor(v1[e], 16); }
                            if (app) { v0 = v0 * c0 + (p0 * s0) * sgn; v1 = v1 * c1 + (p1 * s1) * sgn; }
                        }
                        v0 = v0 * sc; v1 = v1 * sc;
                        u32x4 w; w.x = cvt_pk_bf16(v0[0], v0[1]); w.y = cvt_pk_bf16(v0[2], v0[3]); w.z = cvt_pk_bf16(v1[0], v1[1]); w.w = cvt_pk_bf16(v1[2], v1[3]);
                        *(u32x4*)(rowp + bj * HALF) = w; } }
        }
    }
};
struct EpiRes {
    static constexpr bool PERM = true, AFTER_DRAIN = false;
    const float* base; float* out; bf16_t* hb; float* ssq;
    __device__ __forceinline__ void operator()(const f32x4 (&acc)[2][2][4][2], const Unit& u, int wr, int wc, int fr, int fq) const {
        const int row0 = u.pm * BM + wr * 64 + fr, col0 = u.pn * BM + wc * 32 + 8 * fq;
#pragma unroll
        for (int ai = 0; ai < 2; ++ai)
#pragma unroll
            for (int m = 0; m < 4; ++m) { const int row = row0 + ai * HALF + m * 16; const size_t off = (size_t)row * 1024 + col0; float ss = 0.f;
#pragma unroll
                for (int bj = 0; bj < 2; ++bj) { const f32x4 x0 = *(const f32x4*)(base + off + bj * HALF), x1 = *(const f32x4*)(base + off + bj * HALF + 4);
                    const f32x4 h0 = acc[ai][bj][m][0] + x0, h1 = acc[ai][bj][m][1] + x1;
                    *(f32x4*)(out + off + bj * HALF) = h0; *(f32x4*)(out + off + bj * HALF + 4) = h1;
                    if (hb) { u32x4 w; w.x = cvt_pk_bf16(h0[0], h0[1]); w.y = cvt_pk_bf16(h0[2], h0[3]); w.z = cvt_pk_bf16(h1[0], h1[1]); w.w = cvt_pk_bf16(h1[2], h1[3]); *(u32x4*)(hb + off + bj * HALF) = w; }
                    ss += (h0[0] * h0[0] + h0[1] * h0[1]) + (h0[2] * h0[2] + h0[3] * h0[3]) + (h1[0] * h1[0] + h1[1] * h1[1]) + (h1[2] * h1[2] + h1[3] * h1[3]); }
                ss += __shfl_xor(ss, 16); ss += __shfl_xor(ss, 32);
                if (fq == 0) atomicAdd(ssq + row, ss); }
    }
};
struct EpiFF1 {
    static constexpr bool PERM = true, AFTER_DRAIN = false;
    bf16_t* O; const float* ssq;
    __device__ __forceinline__ void operator()(const f32x4 (&acc)[2][2][4][2], const Unit& u, int wr, int wc, int fr, int fq) const {
        const int row0 = u.pm * BM + wr * 64 + fr, col0 = u.pn * BM + wc * 32 + 8 * fq;
#pragma unroll
        for (int ai = 0; ai < 2; ++ai)
#pragma unroll
            for (int m = 0; m < 4; ++m) { const int row = row0 + ai * HALF + m * 16; const float rs = __builtin_amdgcn_rsqf(ssq[row] * (1.f / 1024.f) + 1e-5f);
                bf16_t* rowp = O + (size_t)row * 4096 + col0;
#pragma unroll
                for (int bj = 0; bj < 2; ++bj) { f32x4 v0 = acc[ai][bj][m][0] * rs, v1 = acc[ai][bj][m][1] * rs;
#pragma unroll
                    for (int e = 0; e < 4; ++e) { const float a = fmaxf(v0[e], 0.f), b = fmaxf(v1[e], 0.f); v0[e] = a * a; v1[e] = b * b; }
                    u32x4 w; w.x = cvt_pk_bf16(v0[0], v0[1]); w.y = cvt_pk_bf16(v0[2], v0[3]); w.z = cvt_pk_bf16(v1[0], v1[1]); w.w = cvt_pk_bf16(v1[2], v1[3]);
                    *(u32x4*)(rowp + bj * HALF) = w; } }
    }
};
}

__device__ __forceinline__ void p0_transpose_item(const float* W, int ldw, int K, const float* scale, bf16* WT, int src_col0, int dst_row0, int k0, float* scr, int lane) {
#pragma unroll 8
    for (int i = 0; i < 32; ++i) { const int kk = 2 * i + (lane >> 5); float v = W[(size_t)(k0 + kk) * ldw + src_col0 + (lane & 31)]; if (scale) v *= scale[k0 + kk]; scr[kk * 33 + (lane & 31)] = v; }
    asm volatile("s_waitcnt lgkmcnt(0)" ::: "memory");
    const int c = lane & 7;
#pragma unroll
    for (int j = 0; j < 4; ++j) { const int n = (lane >> 3) + 8 * j; const float* s = scr + (8 * c) * 33 + n;
        u32x4 o; o.x = cvt_pk_bf16(s[0 * 33], s[1 * 33]); o.y = cvt_pk_bf16(s[2 * 33], s[3 * 33]); o.z = cvt_pk_bf16(s[4 * 33], s[5 * 33]); o.w = cvt_pk_bf16(s[6 * 33], s[7 * 33]);
        *(u32x4*)(WT + (size_t)(dst_row0 + n) * K + k0 + 8 * c) = o; }
    asm volatile("s_waitcnt lgkmcnt(0)" ::: "memory");
}

__device__ __forceinline__ void p0_prologue(const Args& a, unsigned char* lds) {
    const int tid = threadIdx.x, lane = tid & 63, wave = tid >> 6, G = gridDim.x, blk = blockIdx.x;
    unsigned char* ws = a.ws;
    const float* x = a.in[0]; const float* meta = a.in[1]; const float* nmw = a.in[2]; const float* w_in = a.in[3]; const float* wgu = a.in[4];
    const float* w_out = a.in[8]; const float* nfw = a.in[9]; const float* w1 = a.in[10]; const float* w2 = a.in[11];
    bf16* WIN = (bf16*)(ws + WS_WIN); bf16* WO = (bf16*)(ws + WS_WO); bf16* W1 = (bf16*)(ws + WS_W1); bf16* W2 = (bf16*)(ws + WS_W2); bf16* XN = (bf16*)(ws + WS_XN);
    const int gtid = blk * 512 + tid, NT = G * 512;
    for (int e = gtid; e < 32768; e += NT) ((float*)(ws + WS_SSQ2))[e] = 0.f;
    for (int e = gtid; e < (T + NMETA) * 8; e += NT) { const int pos = e >> 3, i = e & 7;
        const float inv = exp2f(-(float)i * (18.931568569324174f * 0.125f)); const float ang = (float)pos * inv;
        double r = (double)ang * 0.15915494309189535; r -= floor(r); const float rf = (float)r;
        float* rp = (float*)(ws + WS_ROPE) + (size_t)pos * 16; rp[i] = __builtin_amdgcn_cosf(rf); rp[8 + i] = __builtin_amdgcn_sinf(rf); }
    if (blk < 17) {
        float* um = (float*)lds; float* red = (float*)(lds + 65536);
        for (int r = 2 * wave; r < 2 * wave + 2; ++r) { const f32x4* xr = (const f32x4*)(meta + (size_t)r * D) + lane; f32x4 v[4]; float s = 0.f;
#pragma unroll
            for (int j = 0; j < 4; ++j) { v[j] = xr[64 * j]; s += (v[j][0] * v[j][0] + v[j][1] * v[j][1]) + (v[j][2] * v[j][2] + v[j][3] * v[j][3]); }
            const float rstd = 1.0f / sqrtf(wave_sum(s) * (1.f / D) + EPS);
#pragma unroll
            for (int j = 0; j < 4; ++j) { const f32x4 w = ((const f32x4*)nmw)[lane + 64 * j]; ((f32x4*)(um + r * D))[lane + 64 * j] = v[j] * rstd * w; } }
        __syncthreads();
        const int col = tid & 63, ks = tid >> 6, j = 64 * blk + col; const bool valid = j < PMW;
        const int src = j < 768 ? 256 + j : (j < 784 ? 1536 + (j - 768) : 2064 + (j - 784));
        float acc[16];
#pragma unroll
        for (int r = 0; r < 16; ++r) acc[r] = 0.f;
        if (valid) for (int k = 128 * ks; k < 128 * ks + 128; k += 4) {
            const float w0 = w_in[(size_t)k * DIN + src], w1_ = w_in[(size_t)(k + 1) * DIN + src], w2_ = w_in[(size_t)(k + 2) * DIN + src], w3 = w_in[(size_t)(k + 3) * DIN + src];
#pragma unroll
            for (int r = 0; r < 16; ++r) { const f32x4 uv = *(const f32x4*)(um + r * D + k); acc[r] += (uv[0] * w0 + uv[1] * w1_) + (uv[2] * w2_ + uv[3] * w3); } }
#pragma unroll
        for (int r = 0; r < 16; ++r) red[(ks * 16 + r) * 64 + col] = acc[r];
        __syncthreads();
        for (int o = tid; o < 1024; o += 512) { const int r = o >> 6, c = o & 63; float s = 0.f;
#pragma unroll
            for (int k2 = 0; k2 < 8; ++k2) s += red[(k2 * 16 + r) * 64 + c];
            if (64 * blk + c < PMW) ((float*)(ws + WS_PM))[r * PMW + 64 * blk + c] = s; }
        __syncthreads();
    }
    for (int e = gtid; e < 256 * 128; e += NT) { const int n = e >> 7, k8 = e & 127; float wg[16];
#pragma unroll
        for (int r = 0; r < 16; ++r) wg[r] = wgu[r * 256 + n];
        float o[8];
#pragma unroll
        for (int kk = 0; kk < 8; ++kk) { const int k = 8 * k8 + kk; const f32x4* p = (const f32x4*)(w_in + (size_t)k * DIN + 1536); float s = 0.f;
#pragma unroll
            for (int q = 0; q < 4; ++q) { const f32x4 v = p[q]; s += (v[0] * wg[4 * q] + v[1] * wg[4 * q + 1]) + (v[2] * wg[4 * q + 2] + v[3] * wg[4 * q + 3]); }
            o[kk] = s * nmw[k]; }
        u32x4 w; w.x = cvt_pk_bf16(o[0], o[1]); w.y = cvt_pk_bf16(o[2], o[3]); w.z = cvt_pk_bf16(o[4], o[5]); w.w = cvt_pk_bf16(o[6], o[7]);
        *(u32x4*)(WIN + (size_t)(2304 + n) * D + 8 * k8) = w; }
    float* scr = (float*)lds + wave * 2112;
    const int gw = blk * 8 + wave, NGW = G * 8;
    constexpr int I_IN = 16 * 72, I_O = 16 * 32, I_1 = 16 * 128, I_2 = 64 * 32, NITEMS = I_IN + I_O + I_1 + I_2;
    for (int it = gw; it < NITEMS; it += NGW) { int r = it;
        if (r < I_IN) { const int kb = r / 72, nb = r % 72, dr = 32 * nb; p0_transpose_item(w_in, DIN, D, nmw, WIN, dr < 1536 ? dr : dr + 16, dr, 64 * kb, scr, lane); continue; } r -= I_IN;
        if (r < I_O) { const int kb = r / 32, nb = r % 32; p0_transpose_item(w_out, D, D, nullptr, WO, 32 * nb, 32 * nb, 64 * kb, scr, lane); continue; } r -= I_O;
        if (r < I_1) { const int kb = r / 128, nb = r % 128; p0_transpose_item(w1, FF, D, nfw, W1, 32 * nb, 32 * nb, 64 * kb, scr, lane); continue; } r -= I_1;
        { const int kb = r / 32, nb = r % 32; p0_transpose_item(w2, D, FF, nullptr, W2, 32 * nb, 32 * nb, 64 * kb, scr, lane); } }
    for (int m = gw; m < M; m += NGW) { const f32x4* xr = (const f32x4*)(x + (size_t)m * D) + lane; f32x4 v[4]; float s = 0.f;
#pragma unroll
        for (int j = 0; j < 4; ++j) { v[j] = xr[64 * j]; s += (v[j][0] * v[j][0] + v[j][1] * v[j][1]) + (v[j][2] * v[j][2] + v[j][3] * v[j][3]); }
        const float rstd = 1.0f / sqrtf(wave_sum(s) * (1.f / D) + EPS);
        u32x2* o8 = (u32x2*)(XN + (size_t)m * D) + lane;
#pragma unroll
        for (int j = 0; j < 4; ++j) { u32x2 w; w.x = cvt_pk_bf16(v[j][0] * rstd, v[j][1] * rstd); w.y = cvt_pk_bf16(v[j][2] * rstd, v[j][3] * rstd); o8[64 * j] = w; } }
}

__device__ __forceinline__ void swa_phase(const Args& a, unsigned char* lds) {
    const int tid = threadIdx.x, lane = tid & 63, w = tid >> 6, fr = lane & 15, fq = lane >> 4;
    unsigned char* ws = a.ws;
    const bf16* P = (const bf16*)(ws + WS_PROJ); const float* PM = (const float*)(ws + WS_PM); const float* rope = (const float*)(ws + WS_ROPE);
    bf16* MIX = (bf16*)(ws + WS_MIX); const float* sinks = a.in[7];
    bf16* KS = (bf16*)lds;
    bf16* VT = (bf16*)(lds + 39168);
    for (int unit = blockIdx.x; unit < 256; unit += gridDim.x) {
        const int b = unit >> 7, n = (unit >> 1) & 63, kv = unit & 1;
        const size_t tok0 = (size_t)b * T + 128 * n;
#pragma unroll
        for (int i = 0; i < 4; ++i) { const int c = tid + 512 * i, jj = c >> 3, dc = c & 7; u32x4 v = {0u, 0u, 0u, 0u};
            if (n > 0 || jj >= 128) v = *(const u32x4*)(P + ((long)tok0 - 128 + jj) * LDP + SK + 64 * kv + 8 * dc);
            *(u32x4*)(KS + (16 + jj) * 72 + 8 * dc) = v; }
        if (tid < 128) { const int t = tid >> 3, dc = tid & 7; const float* src = PM + t * PMW + 784 + 64 * kv;
            f32x4 x0 = *(const f32x4*)(src + 8 * dc), x1 = *(const f32x4*)(src + 8 * dc + 4);
            if (dc < 2) { const f32x4 p0 = *(const f32x4*)(src + 8 * (1 - dc)), p1 = *(const f32x4*)(src + 8 * (1 - dc) + 4); const float* rp = rope + t * 16;
                const f32x4 c0 = *(const f32x4*)rp, c1 = *(const f32x4*)(rp + 4), s0 = *(const f32x4*)(rp + 8), s1 = *(const f32x4*)(rp + 12); const float sgn = dc == 0 ? -1.f : 1.f;
                x0 = x0 * c0 + (p0 * s0) * sgn; x1 = x1 * c1 + (p1 * s1) * sgn; }
            *(u32x4*)(KS + t * 72 + 8 * dc) = pack8(x0, x1);
        } else if (tid < 256) { const int d = tid & 63, hf = (tid >> 6) & 1; const float* src = PM + (8 * hf) * PMW + 912 + 64 * kv + d; float v[8];
#pragma unroll
            for (int i = 0; i < 8; ++i) v[i] = src[i * PMW];
            u32x4 wv; wv.x = cvt_pk_bf16(v[0], v[1]); wv.y = cvt_pk_bf16(v[2], v[3]); wv.z = cvt_pk_bf16(v[4], v[5]); wv.w = cvt_pk_bf16(v[6], v[7]);
            *(u32x4*)(VT + d * 280 + 8 * hf) = wv; }
        { const int d = tid & 63, sg = tid >> 6; unsigned short vr[32];
            const bool ok = (n > 0 || sg >= 4); const bf16* vp = P + ((long)tok0 - 128 + 32 * sg) * LDP + SV + 64 * kv + d;
#pragma unroll
            for (int i = 0; i < 32; ++i) vr[i] = ok ? vp[(long)i * LDP] : (unsigned short)0;
#pragma unroll
            for (int q = 0; q < 4; ++q) { u32x4 wv; wv.x = vr[8 * q] | ((unsigned)vr[8 * q + 1] << 16); wv.y = vr[8 * q + 2] | ((unsigned)vr[8 * q + 3] << 16); wv.z = vr[8 * q + 4] | ((unsigned)vr[8 * q + 5] << 16); wv.w = vr[8 * q + 6] | ((unsigned)vr[8 * q + 7] << 16);
                *(u32x4*)(VT + d * 280 + 16 + 32 * sg + 8 * q) = wv; } }
        __syncthreads();
        const int gh = w >> 1, th = w & 1, qh = 4 * kv + gh; const float sink2 = sinks[qh] * LOG2E;
        for (int it = 0; it < 4; ++it) {
            const int r0 = 64 * th + 16 * it; const size_t qrow = tok0 + r0 + fr;
            bf16x8 qf[2];
#pragma unroll
            for (int kk = 0; kk < 2; ++kk) qf[kk] = *(const bf16x8*)(P + qrow * LDP + SQ + 64 * qh + 32 * kk + 8 * fq);
            f32x4 s[10];
#pragma unroll
            for (int tl = 0; tl < 10; ++tl) { const int krow0 = tl == 0 ? 0 : 16 + r0 + 16 * (tl - 1); f32x4 acc = {0.f, 0.f, 0.f, 0.f};
#pragma unroll
                for (int kk = 0; kk < 2; ++kk) { const bf16x8 kf = *(const bf16x8*)(KS + (krow0 + fr) * 72 + 32 * kk + 8 * fq); acc = __builtin_amdgcn_mfma_f32_16x16x32_bf16(kf, qf[kk], acc, 0, 0, 0); }
                s[tl] = acc; }
            float mx = sink2; const int rr = r0 + fr;
#pragma unroll
            for (int tl = 0; tl < 10; ++tl)
#pragma unroll
                for (int e = 0; e < 4; ++e) { float v = s[tl][e] * LOG2E;
                    if (tl > 0) { const int jj = r0 + 16 * (tl - 1) + 4 * fq + e, dist = 128 + rr - jj; const bool ok = dist >= 0 && dist < 128 && (n > 0 || jj >= 128); v = ok ? v : -INFINITY; }
                    s[tl][e] = v; mx = fmaxf(mx, v); }
            mx = fmaxf(mx, __shfl_xor(mx, 16)); mx = fmaxf(mx, __shfl_xor(mx, 32));
            float l = 0.f;
#pragma unroll
            for (int tl = 0; tl < 10; ++tl)
#pragma unroll
                for (int e = 0; e < 4; ++e) { const float p = __builtin_amdgcn_exp2f(s[tl][e] - mx); s[tl][e] = p; l += p; }
            l += __shfl_xor(l, 16); l += __shfl_xor(l, 32); l += __builtin_amdgcn_exp2f(sink2 - mx);
            const float rl = 1.0f / l;
            f32x4 o[4];
#pragma unroll
            for (int dt = 0; dt < 4; ++dt) o[dt] = (f32x4){0.f, 0.f, 0.f, 0.f};
#pragma unroll
            for (int pr = 0; pr < 5; ++pr) { const int ta = 2 * pr, tb = 2 * pr + 1;
                const int ka = ta == 0 ? 0 : 16 + r0 + 16 * (ta - 1), kb = 16 + r0 + 16 * (tb - 1);
                const u32x4 pw = pack8(s[ta], s[tb]); const bf16x8 pf = __builtin_bit_cast(bf16x8, pw);
#pragma unroll
                for (int dt = 0; dt < 4; ++dt) { const bf16* vrow = VT + (16 * dt + fr) * 280 + 4 * fq;
                    const u32x2 va = *(const u32x2*)(vrow + ka), vb = *(const u32x2*)(vrow + kb); const u32x4 vw = {va.x, va.y, vb.x, vb.y};
                    o[dt] = __builtin_amdgcn_mfma_f32_16x16x32_bf16(__builtin_bit_cast(bf16x8, vw), pf, o[dt], 0, 0, 0); } }
#pragma unroll
            for (int dt = 0; dt < 4; ++dt) { u32x2 wv; wv.x = cvt_pk_bf16(o[dt][0] * rl, o[dt][1] * rl); wv.y = cvt_pk_bf16(o[dt][2] * rl, o[dt][3] * rl);
                *(u32x2*)(MIX + qrow * D + 512 + 64 * qh + 16 * dt + 4 * fq) = wv; }
        }
        __syncthreads();
    }
}

__device__ __forceinline__ void gla_local_phase(const Args& a, unsigned char* lds) {
    const int tid = threadIdx.x, hb = tid >> 8, t256 = tid & 255, lane = tid & 63, w4 = (tid >> 6) & 3, fr = lane & 15, fq = lane >> 4;
    unsigned char* ws = a.ws;
    const bf16* P = (const bf16*)(ws + WS_PROJ); const float* G = (const float*)(ws + WS_G); float* DST = (float*)(ws + WS_DST); float* DC = (float*)(ws + WS_DC);
    unsigned char* base = lds + hb * 28672;
    bf16* KT = (bf16*)base; bf16* VT = (bf16*)(base + 9216); float* tot = (float*)(base + 27648);
    for (int p = blockIdx.x; p < 512; p += gridDim.x) {
        const int v = 2 * p + hb, h = v & 3, c = (v >> 2) & 127, b = v >> 9; const size_t row0 = (size_t)b * T + 64 * c; const int uidx = (b * 4 + h) * 128 + c;
        const int i = t256 & 63, seg = t256 >> 6;
        float bc[16];
        { const float* gp = G + (row0 + 16 * seg) * 256 + 64 * h + i; float run = 0.f;
#pragma unroll
            for (int tt = 0; tt < 16; ++tt) { run += gp[tt * 256]; bc[tt] = run; } }
        tot[seg * 64 + i] = bc[15];
        unsigned short kr[16];
        { const bf16* kp = P + (row0 + 16 * seg) * LDP + GK + 64 * h + i;
#pragma unroll
            for (int tt = 0; tt < 16; ++tt) kr[tt] = kp[(size_t)tt * LDP]; }
        const int j = t256 & 127, sg = t256 >> 7; unsigned short vr[32];
        { const bf16* vp = P + (row0 + 32 * sg) * LDP + GV + 128 * h + j;
#pragma unroll
            for (int tt = 0; tt < 32; ++tt) vr[tt] = vp[(size_t)tt * LDP]; }
        __syncthreads();
        float off = 0.f, total = 0.f;
#pragma unroll
        for (int s = 0; s < 4; ++s) { const float xv = tot[s * 64 + i]; total += xv; if (s < seg) off += xv; }
        float kt[16];
#pragma unroll
        for (int tt = 0; tt < 16; ++tt) kt[tt] = bf2f(kr[tt]) * fexp(total - (bc[tt] + off));
        { u32x4 w0, w1; w0.x = cvt_pk_bf16(kt[0], kt[1]); w0.y = cvt_pk_bf16(kt[2], kt[3]); w0.z = cvt_pk_bf16(kt[4], kt[5]); w0.w = cvt_pk_bf16(kt[6], kt[7]);
            w1.x = cvt_pk_bf16(kt[8], kt[9]); w1.y = cvt_pk_bf16(kt[10], kt[11]); w1.z = cvt_pk_bf16(kt[12], kt[13]); w1.w = cvt_pk_bf16(kt[14], kt[15]);
            *(u32x4*)(KT + i * 72 + 16 * seg) = w0; *(u32x4*)(KT + i * 72 + 16 * seg + 8) = w1; }
        if (seg == 3) DC[uidx * 64 + i] = fexp(total);
#pragma unroll
        for (int q = 0; q < 4; ++q) { u32x4 wv; wv.x = vr[8 * q] | ((unsigned)vr[8 * q + 1] << 16); wv.y = vr[8 * q + 2] | ((unsigned)vr[8 * q + 3] << 16); wv.z = vr[8 * q + 4] | ((unsigned)vr[8 * q + 5] << 16); wv.w = vr[8 * q + 6] | ((unsigned)vr[8 * q + 7] << 16);
            *(u32x4*)(VT + j * 72 + 32 * sg + 8 * q) = wv; }
        __syncthreads();
        f32x4 acc[8];
#pragma unroll
        for (int jt = 0; jt < 8; ++jt) acc[jt] = (f32x4){0.f, 0.f, 0.f, 0.f};
#pragma unroll
        for (int kk = 0; kk < 2; ++kk) { const bf16x8 af = *(const bf16x8*)(KT + (16 * w4 + fr) * 72 + 32 * kk + 8 * fq);
#pragma unroll
            for (int jt = 0; jt < 8; ++jt) { const bf16x8 bfr = *(const bf16x8*)(VT + (16 * jt + fr) * 72 + 32 * kk + 8 * fq); acc[jt] = __builtin_amdgcn_mfma_f32_16x16x32_bf16(af, bfr, acc[jt], 0, 0, 0); } }
        float* dst = DST + (size_t)uidx * 8192;
#pragma unroll
        for (int jt = 0; jt < 8; ++jt) *(f32x4*)(dst + (16 * jt + fr) * 64 + 16 * w4 + 4 * fq) = acc[jt];
        __syncthreads();
    }
}

__device__ __forceinline__ void gla_scan_phase(const Args& a) {
    const int tid = threadIdx.x; if (tid >= 256) return;
    unsigned char* ws = a.ws;
    const float* PM = (const float*)(ws + WS_PM); const float* DST = (const float*)(ws + WS_DST); const float* DC = (const float*)(ws + WS_DC); bf16* ST = (bf16*)(ws + WS_ST);
    const float* wgu = a.in[4]; const float* bgate = a.in[5];
    for (int ge = blockIdx.x * 256 + tid; ge < 65536; ge += gridDim.x * 256) {
        const int bh = ge >> 13, e = ge & 8191, i = e & 63, j = e >> 6, h = bh & 3;
        float S = 0.f;
        { float bc[16]; float run = 0.f; const int gi = 64 * h + i; const float bg = bgate[gi]; float wg[16];
#pragma unroll
            for (int r = 0; r < 16; ++r) wg[r] = wgu[r * 256 + gi];
#pragma unroll
            for (int t = 0; t < 16; ++t) { float lg = bg;
#pragma unroll
                for (int r = 0; r < 16; ++r) lg += PM[t * PMW + 768 + r] * wg[r];
                run += logsig(lg) * 0.0625f; bc[t] = run; }
#pragma unroll
            for (int t = 0; t < 16; ++t) S += PM[t * PMW + gi] * fexp(run - bc[t]) * PM[t * PMW + 256 + 128 * h + j]; }
        const size_t ub = (size_t)bh * 128;
        for (int c0 = 0; c0 < 128; c0 += 8) { float ds[8], dc[8];
#pragma unroll
            for (int q = 0; q < 8; ++q) { ds[q] = DST[(ub + c0 + q) * 8192 + e]; dc[q] = DC[(ub + c0 + q) * 64 + i]; }
#pragma unroll
            for (int q = 0; q < 8; ++q) { ST[(ub + c0 + q) * 8192 + e] = (bf16)(cvt_pk_bf16(S, 0.f) & 0xffffu); S = dc[q] * S + ds[q]; } }
    }
}

__device__ __forceinline__ void gla_out_phase(const Args& a, unsigned char* lds) {
    const int tid = threadIdx.x, hb = tid >> 8, t256 = tid & 255, lane = tid & 63, w4 = (tid >> 6) & 3, fr = lane & 15, fq = lane >> 4;
    unsigned char* ws = a.ws;
    const bf16* P = (const bf16*)(ws + WS_PROJ); const float* G = (const float*)(ws + WS_G); const bf16* ST = (const bf16*)(ws + WS_ST); bf16* MIX = (bf16*)(ws + WS_MIX);
    const float* gnw = a.in[6];
    unsigned char* base = lds + hb * 47104;
    bf16* QS = (bf16*)base; bf16* KS = (bf16*)(base + 9216); bf16* VT = (bf16*)(base + 18432); bf16* AS = (bf16*)(base + 36864); float* tot = (float*)(base + 46080);
    for (int p = blockIdx.x; p < 512; p += gridDim.x) {
        const int v = 2 * p + hb, h = v & 3, c = (v >> 2) & 127, b = v >> 9; const size_t row0 = (size_t)b * T + 64 * c; const int uidx = (b * 4 + h) * 128 + c;
        bf16x8 sf[8][2];
        { const bf16* su = ST + (size_t)uidx * 8192;
#pragma unroll
            for (int jt = 0; jt < 8; ++jt)
#pragma unroll
                for (int kk = 0; kk < 2; ++kk) sf[jt][kk] = *(const bf16x8*)(su + (16 * jt + fr) * 64 + 32 * kk + 8 * fq); }
        const int i = t256 & 63, seg = t256 >> 6;
        float bc[16];
        { const float* gp = G + (row0 + 16 * seg) * 256 + 64 * h + i; float run = 0.f;
#pragma unroll
            for (int tt = 0; tt < 16; ++tt) { run += gp[tt * 256]; bc[tt] = run; } }
        tot[seg * 64 + i] = bc[15];
        unsigned short qr[16], kr[16];
        { const bf16* qp = P + (row0 + 16 * seg) * LDP + GQ + 64 * h + i;
#pragma unroll
            for (int tt = 0; tt < 16; ++tt) { qr[tt] = qp[(size_t)tt * LDP]; kr[tt] = qp[(size_t)tt * LDP + (GK - GQ)]; } }
        const int j = t256 & 127, sg = t256 >> 7; unsigned short vr[32];
        { const bf16* vp = P + (row0 + 32 * sg) * LDP + GV + 128 * h + j;
#pragma unroll
            for (int tt = 0; tt < 32; ++tt) vr[tt] = vp[(size_t)tt * LDP]; }
        __syncthreads();
        float off = 0.f;
#pragma unroll
        for (int s = 0; s < 3; ++s) { const float xv = tot[s * 64 + i]; if (s < seg) off += xv; }
#pragma unroll
        for (int tt = 0; tt < 16; ++tt) { const float bb = bc[tt] + off; const float qv = bf2f(qr[tt]) * fexp(bb), kv = bf2f(kr[tt]) * fexp(-bb);
            const unsigned w = cvt_pk_bf16(qv, kv); QS[(16 * seg + tt) * 72 + i] = (bf16)(w & 0xffffu); KS[(16 * seg + tt) * 72 + i] = (bf16)(w >> 16); }
#pragma unroll
        for (int q = 0; q < 4; ++q) { u32x4 wv; wv.x = vr[8 * q] | ((unsigned)vr[8 * q + 1] << 16); wv.y = vr[8 * q + 2] | ((unsigned)vr[8 * q + 3] << 16); wv.z = vr[8 * q + 4] | ((unsigned)vr[8 * q + 5] << 16); wv.w = vr[8 * q + 6] | ((unsigned)vr[8 * q + 7] << 16);
            *(u32x4*)(VT + j * 72 + 32 * sg + 8 * q) = wv; }
        __syncthreads();
        bf16x8 qa[2];
#pragma unroll
        for (int kk = 0; kk < 2; ++kk) qa[kk] = *(const bf16x8*)(QS + (16 * w4 + fr) * 72 + 32 * kk + 8 * fq);
#pragma unroll
        for (int st = 0; st < 4; ++st) { f32x4 acc = {0.f, 0.f, 0.f, 0.f};
#pragma unroll
            for (int kk = 0; kk < 2; ++kk) { const bf16x8 kb = *(const bf16x8*)(KS + (16 * st + fr) * 72 + 32 * kk + 8 * fq); acc = __builtin_amdgcn_mfma_f32_16x16x32_bf16(qa[kk], kb, acc, 0, 0, 0); }
#pragma unroll
            for (int r = 0; r < 4; ++r) { const int t = 16 * w4 + 4 * fq + r, s = 16 * st + fr; const float val = s <= t ? acc[r] : 0.f; AS[t * 72 + s] = (bf16)(cvt_pk_bf16(val, 0.f) & 0xffffu); } }
        __syncthreads();
        f32x4 o[8];
#pragma unroll
        for (int jt = 0; jt < 8; ++jt) o[jt] = (f32x4){0.f, 0.f, 0.f, 0.f};
#pragma unroll
        for (int kk = 0; kk < 2; ++kk) { const bf16x8 a1 = *(const bf16x8*)(AS + (16 * w4 + fr) * 72 + 32 * kk + 8 * fq);
#pragma unroll
            for (int jt = 0; jt < 8; ++jt) { const bf16x8 vb = *(const bf16x8*)(VT + (16 * jt + fr) * 72 + 32 * kk + 8 * fq);
                o[jt] = __builtin_amdgcn_mfma_f32_16x16x32_bf16(a1, vb, o[jt], 0, 0, 0); o[jt] = __builtin_amdgcn_mfma_f32_16x16x32_bf16(qa[kk], sf[jt][kk], o[jt], 0, 0, 0); } }
        float rs[4];
#pragma unroll
        for (int r = 0; r < 4; ++r) { float ss = 0.f;
#pragma unroll
            for (int jt = 0; jt < 8; ++jt) ss += o[jt][r] * o[jt][r];
            ss += __shfl_xor(ss, 1); ss += __shfl_xor(ss, 2); ss += __shfl_xor(ss, 4); ss += __shfl_xor(ss, 8);
            rs[r] = 1.0f / sqrtf(ss * (1.f / 128.f) + EPS); }
#pragma unroll
        for (int jt = 0; jt < 8; ++jt) { const int jc = 16 * jt + fr; const float gw_ = gnw[jc];
#pragma unroll
            for (int r = 0; r < 4; ++r) { const size_t row = row0 + 16 * w4 + 4 * fq + r; const float rg = bf2f(P[row * LDP + GR + 128 * h + jc]);
                const float sl = rg / (1.f + fexp(-rg)); const float val = o[jt][r] * rs[r] * gw_ * sl;
                MIX[row * D + 128 * h + jc] = (bf16)(cvt_pk_bf16(val, 0.f) & 0xffffu); } }
        __syncthreads();
    }
}

__device__ __forceinline__ void final_norm_phase(const Args& a) {
    const int tid = threadIdx.x, lane = tid & 63, wave = tid >> 6; const float* ssq = (const float*)(a.ws + WS_SSQ3); const float* fw = a.in[12];
    f32x4 w[4];
#pragma unroll
    for (int j = 0; j < 4; ++j) w[j] = ((const f32x4*)fw)[lane + 64 * j];
    for (int m = blockIdx.x * 8 + wave; m < M; m += gridDim.x * 8) { f32x4* xr = (f32x4*)(a.out + (size_t)m * D) + lane; const float rstd = 1.0f / sqrtf(ssq[m] * (1.f / D) + EPS);
#pragma unroll
        for (int j = 0; j < 4; ++j) xr[64 * j] = xr[64 * j] * rstd * w[j]; }
}

__global__ void __launch_bounds__(512, 2) hybrid_fwd(Args a) {
    extern __shared__ __attribute__((aligned(16))) unsigned char lds[];
    PG8_LAS unsigned char* lds3 = (PG8_LAS unsigned char*)lds;
    unsigned char* ws = a.ws; const int G = gridDim.x;
    const int lo = a.ph_lo, hi = a.ph_hi;
#define IN(k) (lo <= (k) && (k) < hi)
#if MK_MULTI
#define SEAM(k) do { } while (0)
#else
#define SEAM(k) do { if (IN(k) && IN((k) + 1)) cg::this_grid().sync(); } while (0)
#endif
    if (IN(0)) p0_prologue(a, lds);
    SEAM(0);
    if (IN(1)) { pg8::Gemm g{(const bf16*)(ws + WS_XN), (const bf16*)(ws + WS_WIN), M, NIN, D}; pg8::StaticOrder S; S.init(M, NIN, G, (int)blockIdx.x);
        pg8::EpiIn E{(bf16*)(ws + WS_PROJ), (float*)(ws + WS_G), a.in[5], (const float*)(ws + WS_ROPE)};
        pg8::gemm_phase<pg8::EpiIn, pg8::StaticOrder, true, true>(lds3, g, S, E); }
    SEAM(1);
    if (IN(2)) { swa_phase(a, lds); gla_local_phase(a, lds); }
    SEAM(2);
    if (IN(3)) gla_scan_phase(a);
    SEAM(3);
    if (IN(4)) gla_out_phase(a, lds);
    SEAM(4);
    if (IN(5)) { pg8::Gemm g{(const bf16*)(ws + WS_MIX), (const bf16*)(ws + WS_WO), M, D, D}; pg8::StaticOrder S; S.init(M, D, G, (int)blockIdx.x);
        pg8::EpiRes E{a.in[0], a.out, (bf16*)(ws + WS_XN), (float*)(ws + WS_SSQ2)};
        pg8::gemm_phase<pg8::EpiRes, pg8::StaticOrder, true, true>(lds3, g, S, E); }
    SEAM(5);
    if (IN(6)) { pg8::Gemm g{(const bf16*)(ws + WS_XN), (const bf16*)(ws + WS_W1), M, FF, D}; pg8::StaticOrder S; S.init(M, FF, G, (int)blockIdx.x);
        pg8::EpiFF1 E{(bf16*)(ws + WS_ACT), (const float*)(ws + WS_SSQ2)};
        pg8::gemm_phase<pg8::EpiFF1, pg8::StaticOrder, true, true>(lds3, g, S, E); }
    SEAM(6);
    if (IN(7)) { pg8::Gemm g{(const bf16*)(ws + WS_ACT), (const bf16*)(ws + WS_W2), M, D, FF}; pg8::StaticOrder S; S.init(M, D, G, (int)blockIdx.x);
        pg8::EpiRes E{a.out, a.out, nullptr, (float*)(ws + WS_SSQ3)};
        pg8::gemm_phase<pg8::EpiRes, pg8::StaticOrder, true, true>(lds3, g, S, E); }
    SEAM(7);
    if (IN(8)) final_norm_phase(a);
#undef IN
#undef SEAM
}

extern "C" void kernel_launch(void* const* d_in, const int* in_sizes, int n_in, void* d_out, int out_size, void* d_ws, size_t ws_size, hipStream_t stream) {
    static int grid = 0;
    if (grid == 0) {
        if (n_in != 13 || in_sizes[0] != M * D || out_size != M * D || ws_size < WS_END) { fprintf(stderr, "kernel_launch: unexpected shapes (n_in %d in0 %d out %d ws %zu)\n", n_in, n_in > 0 ? in_sizes[0] : -1, out_size, ws_size); grid = -1; return; }
        int dev = 0, cus = 0, per_cu = 0;
        (void)hipGetDevice(&dev); (void)hipDeviceGetAttribute(&cus, hipDeviceAttributeMultiprocessorCount, dev);
        if (hipFuncSetAttribute((const void*)hybrid_fwd, hipFuncAttributeMaxDynamicSharedMemorySize, LDS_BYTES) != hipSuccess) { fprintf(stderr, "kernel_launch: hipFuncSetAttribute failed\n"); grid = -1; return; }
        if (hipOccupancyMaxActiveBlocksPerMultiprocessor(&per_cu, (const void*)hybrid_fwd, 512, LDS_BYTES) != hipSuccess || per_cu < 1) { fprintf(stderr, "kernel_launch: occupancy query says %d\n", per_cu); per_cu = 1; }
        (void)hipGetLastError();
        grid = cus * 1;
        if (grid <= 0) grid = 256;
    }
    if (grid < 0) return;
    Args a{};
    for (int i = 0; i < 13; ++i) a.in[i] = (const float*)d_in[i];
    a.out = (float*)d_out; a.ws = (unsigned char*)d_ws;
#if MK_MULTI
    for (int ph = 0; ph < 9; ++ph) { a.ph_lo = ph; a.ph_hi = ph + 1; hipLaunchKernelGGL(hybrid_fwd, dim3(grid), dim3(512), LDS_BYTES, stream, a); }
#else
    a.ph_lo = 0; a.ph_hi = 9;
    void* args[] = {&a};
    hipError_t e = hipLaunchCooperativeKernel((const void*)hybrid_fwd, dim3(grid), dim3(512), args, LDS_BYTES, stream);
    if (e != hipSuccess) fprintf(stderr, "cooperative launch failed: %s (grid %d)\n", hipGetErrorString(e), grid);
#endif
}
```

```cpp
#include <hip/hip_runtime.h>
#include <hip/hip_cooperative_groups.h>
#include <cstdio>
#include <cstdint>
namespace cg = cooperative_groups;
namespace pg8 {
#define PG8_LAS __attribute__((address_space(3)))
typedef unsigned short bf16_t;
typedef short bf16x8 __attribute__((ext_vector_type(8)));
typedef float f32x4 __attribute__((ext_vector_type(4)));
typedef unsigned u32x4 __attribute__((ext_vector_type(4)));
constexpr int BM = 256, BK = 64, HALF = 128, HTB = HALF * BK * 2  , STAGE_BYTES = 8 * HTB, NXCD = 8, WGM = 8;

__host__ __device__ __forceinline__ int lds_byte(int r, int c) { const int st = (r >> 4) * 2 + (c >> 5), rr = r & 15, cc = c & 31, ob = rr * 64 + cc * 2; return st * 1024 + (ob ^ (((ob >> 9) & 1) << 5)); }
__host__ __device__ __forceinline__ void stage_rc(int b, int& R, int& C) { const int st = b / 1024, sb = b % 1024, swz = sb ^ (((sb >> 9) & 1) << 5); R = (st >> 1) * 16 + swz / 64; C = (st & 1) * 32 + (swz % 64) / 2; }
__host__ __device__ __forceinline__ int perm32(int rho) { const int n = rho >> 4, i = rho & 15; return 8 * (i >> 2) + 4 * n + (i & 3); }

struct Unit { int pm, pn; };
struct Gemm { const bf16_t* A; const bf16_t* Bt; int M, N, K; };

struct StaticOrder {
    int nM, nN, nwg, G, c;
    __host__ __device__ void init(int M, int N, int G_, int c_) { nM = M / BM; nN = N / BM; nwg = nM * nN; G = G_; c = c_; }
    __host__ __device__ bool next(int i, Unit& u) const {
        const long L = (long)i * G + c; if (L >= nwg) return false;
        int wgid = (int)L; { const int q = nwg / NXCD, r = nwg % NXCD, xcd = wgid % NXCD, off = wgid / NXCD; wgid = (xcd < r ? xcd * (q + 1) : r * (q + 1) + (xcd - r) * q) + off; }
        const int nig = WGM * nN, gid = wgid / nig, fm = gid * WGM, gsz = (nM - fm) < WGM ? (nM - fm) : WGM;
        u.pm = fm + ((wgid % nig) % gsz); u.pn = (wgid % nig) / gsz; return true;
    }
    __device__ __forceinline__ void a_ready(const Unit&) const {}
    __device__ __forceinline__ void done(const Unit&) const {}
};

__device__ __forceinline__ unsigned cvt_pk_bf16(float lo, float hi) { unsigned r; asm volatile("v_cvt_pk_bf16_f32 %0, %1, %2" : "=v"(r) : "v"(lo), "v"(hi)); return r; }
typedef float f32x2 __attribute__((ext_vector_type(2)));
template <class Epi, class Sched, bool ALIGN_EPI = false, bool SP2 = false>
__device__ __forceinline__ void gemm_phase(PG8_LAS unsigned char* lds, const Gemm g, const Sched& S, const Epi& E) {
    const int tid = threadIdx.x, wid = __builtin_amdgcn_readfirstlane(tid >> 6), lane = tid & 63, wr = wid >> 2, wc = wid & 3, fr = lane & 15, fq = lane >> 4;
    const int K = g.K, nt = K / BK;
    unsigned voffA[2], voffB[2];
#pragma unroll
    for (int i = 0; i < 2; ++i) { int R, C; stage_rc(tid * 16 + i * 8192, R, C); const int Rb = Epi::PERM ? ((R & ~31) + perm32(R & 31)) : R;
        voffA[i] = (unsigned)(R * K + C) * 2u; voffB[i] = (unsigned)(Rb * K + C) * 2u; }
    const size_t kstep = (size_t)(BK * 2);
    const size_t hstep = (size_t)HALF * K * 2;
    const size_t tstep = 2 * hstep;
    const unsigned ldsw = (unsigned)wid * 1024u;
    const int aoff = lds_byte(wr * 64 + fr, fq * 8), boff = lds_byte(wc * 32 + fr, fq * 8);
#define PG8_SA(b, h) (((b) * 2 + (h)) * HTB)
#define PG8_SB(b, h) ((4 + (b) * 2 + (h)) * HTB)
#define PG8_STAGE(bufoff, gbase, voff) do { _Pragma("unroll") for (int _i = 0; _i < 2; ++_i) \
        __builtin_amdgcn_global_load_lds((const unsigned*)((const char*)(gbase) + (voff)[_i]), (PG8_LAS unsigned*)(lds + (bufoff) + ldsw + _i * 8192), 16, 0, 0); } while (0)
#define PG8_LDA(dst, b, h) do { _Pragma("unroll") for (int m = 0; m < 4; ++m) _Pragma("unroll") for (int k = 0; k < 2; ++k) dst[m][k] = *(const PG8_LAS bf16x8*)(lds + PG8_SA(b, h) + aoff + m * 2048 + k * 1024); } while (0)
#define PG8_LDB(dst, b, h) do { _Pragma("unroll") for (int n = 0; n < 2; ++n) _Pragma("unroll") for (int k = 0; k < 2; ++k) dst[n][k] = *(const PG8_LAS bf16x8*)(lds + PG8_SB(b, h) + boff + n * 2048 + k * 1024); } while (0)
#define PG8_MMA(ai, bj, At, Bt) do { __builtin_amdgcn_s_setprio(1); _Pragma("unroll") for (int m = 0; m < 4; ++m) _Pragma("unroll") for (int n = 0; n < 2; ++n) _Pragma("unroll") for (int k = 0; k < 2; ++k) \
        acc[ai][bj][m][n] = __builtin_amdgcn_mfma_f32_16x16x32_bf16(Bt[n][k], At[m][k], acc[ai][bj][m][n], 0, 0, 0); __builtin_amdgcn_s_setprio(0); } while (0)
#define PG8_WAIT_V(n) asm volatile("s_waitcnt vmcnt(" #n ")" ::: "memory")
#define PG8_WAIT_L(n) asm volatile("s_waitcnt lgkmcnt(" #n ")" ::: "memory")
#define PG8_BAR __builtin_amdgcn_s_barrier()
#define PG8_SCHED __builtin_amdgcn_sched_barrier(0)
    Unit cur, nxt; int ui = 0;
    if (!S.next(0, cur)) return;
    f32x4 acc[2][2][4][2];
#pragma unroll
    for (int a = 0; a < 2; ++a)
#pragma unroll
        for (int b = 0; b < 2; ++b)
#pragma unroll
            for (int m = 0; m < 4; ++m)
#pragma unroll
                for (int n = 0; n < 2; ++n) acc[a][b][m][n] = (f32x4){0.f, 0.f, 0.f, 0.f};
    bf16x8 At[4][2], B0[2][2], B1[2][2];
    const char* cA = (const char*)g.A + (size_t)cur.pm * tstep; const char* cB = (const char*)g.Bt + (size_t)cur.pn * tstep;
    S.a_ready(cur);
    if constexpr (SP2) {
        PG8_STAGE(PG8_SB(0, 0), cB, voffB); PG8_STAGE(PG8_SB(0, 1), cB + hstep, voffB); PG8_STAGE(PG8_SA(0, 0), cA, voffA); PG8_STAGE(PG8_SA(0, 1), cA + hstep, voffA);
        if (wr == 1) PG8_BAR;
        PG8_WAIT_V(2); PG8_BAR;
        PG8_STAGE(PG8_SB(1, 0), cB + kstep, voffB); PG8_STAGE(PG8_SA(1, 0), cA + kstep, voffA); PG8_STAGE(PG8_SB(1, 1), cB + hstep + kstep, voffB);
        PG8_WAIT_V(6); PG8_BAR;
    } else {
        PG8_STAGE(PG8_SB(0, 0), cB, voffB); PG8_STAGE(PG8_SA(0, 0), cA, voffA); PG8_STAGE(PG8_SB(0, 1), cB + hstep, voffB); PG8_STAGE(PG8_SA(0, 1), cA + hstep, voffA);
        if (wr == 1) PG8_BAR;
        PG8_WAIT_V(4); PG8_BAR;
        PG8_STAGE(PG8_SB(1, 0), cB + kstep, voffB); PG8_STAGE(PG8_SA(1, 0), cA + kstep, voffA); PG8_STAGE(PG8_SB(1, 1), cB + hstep + kstep, voffB);
        PG8_WAIT_V(6); PG8_BAR;
    }
    for (;;) {
        const bool has_next = S.next(ui + 1, nxt);
        const char* nA = has_next ? (const char*)g.A + (size_t)nxt.pm * tstep : cA; const char* nB = has_next ? (const char*)g.Bt + (size_t)nxt.pn * tstep : cB;
        for (int t = 0; t < nt; t += 2) {
            const bool last = (t == nt - 2);
            const char* a1 = cA + (size_t)(t + 1) * kstep;
            const char* a2 = last ? nA : cA + (size_t)(t + 2) * kstep; const char* b2 = last ? nB : cB + (size_t)(t + 2) * kstep;
            const char* a3 = a2 + kstep; const char* b3 = b2 + kstep;
            if (last && has_next) S.a_ready(nxt);
            if constexpr (SP2) {
            PG8_LDB(B0, 0, 0); PG8_LDB(B1, 0, 1); PG8_SCHED; PG8_LDA(At, 0, 0); PG8_STAGE(PG8_SA(1, 1), a1 + hstep, voffA);
            PG8_WAIT_V(8); PG8_WAIT_L(0); PG8_BAR; PG8_MMA(0, 0, At, B0); PG8_MMA(0, 1, At, B1); PG8_BAR; PG8_SCHED;
            PG8_LDA(At, 0, 1); PG8_STAGE(PG8_SB(0, 0), b2, voffB); PG8_STAGE(PG8_SB(0, 1), b2 + hstep, voffB); PG8_STAGE(PG8_SA(0, 0), a2, voffA);
            PG8_WAIT_V(8); PG8_WAIT_L(0); PG8_BAR; PG8_MMA(1, 0, At, B0); PG8_MMA(1, 1, At, B1); PG8_BAR; PG8_SCHED;
            PG8_LDB(B0, 1, 0); PG8_LDB(B1, 1, 1); PG8_SCHED; PG8_LDA(At, 1, 0); PG8_STAGE(PG8_SA(0, 1), a2 + hstep, voffA);
            PG8_WAIT_V(8); PG8_WAIT_L(0); PG8_BAR; PG8_MMA(0, 0, At, B0); PG8_MMA(0, 1, At, B1); PG8_BAR; PG8_SCHED;
            PG8_LDA(At, 1, 1); PG8_STAGE(PG8_SB(1, 0), b3, voffB); PG8_STAGE(PG8_SB(1, 1), b3 + hstep, voffB); PG8_STAGE(PG8_SA(1, 0), a3, voffA);
            PG8_WAIT_V(8); PG8_WAIT_L(0); PG8_BAR; PG8_MMA(1, 0, At, B0); PG8_MMA(1, 1, At, B1); PG8_BAR; PG8_SCHED;
            } else {
            PG8_LDB(B0, 0, 0); PG8_SCHED; PG8_LDA(At, 0, 0); PG8_STAGE(PG8_SA(1, 1), a1 + hstep, voffA);
            PG8_WAIT_L(8); PG8_BAR; PG8_WAIT_L(0); PG8_MMA(0, 0, At, B0); PG8_BAR; PG8_SCHED;
            PG8_LDB(B1, 0, 1); PG8_STAGE(PG8_SB(0, 0), b2, voffB);
            PG8_BAR; PG8_WAIT_L(0); PG8_MMA(0, 1, At, B1); PG8_BAR;
            PG8_LDA(At, 0, 1); PG8_STAGE(PG8_SA(0, 0), a2, voffA);
            PG8_BAR; PG8_WAIT_L(0); PG8_MMA(1, 0, At, B0); PG8_BAR; PG8_SCHED;
            PG8_STAGE(PG8_SB(0, 1), b2 + hstep, voffB);
            PG8_WAIT_V(6); PG8_BAR; PG8_MMA(1, 1, At, B1); PG8_BAR;
            PG8_LDB(B0, 1, 0); PG8_SCHED; PG8_LDA(At, 1, 0); PG8_STAGE(PG8_SA(0, 1), a2 + hstep, voffA);
            PG8_WAIT_L(8); PG8_BAR; PG8_WAIT_L(0); PG8_MMA(0, 0, At, B0); PG8_BAR; PG8_SCHED;
            PG8_LDB(B1, 1, 1); PG8_STAGE(PG8_SB(1, 0), b3, voffB);
            PG8_BAR; PG8_WAIT_L(0); PG8_MMA(0, 1, At, B1); PG8_BAR;
            PG8_LDA(At, 1, 1); PG8_STAGE(PG8_SA(1, 0), a3, voffA);
            PG8_BAR; PG8_WAIT_L(0); PG8_MMA(1, 0, At, B0); PG8_BAR; PG8_SCHED;
            PG8_STAGE(PG8_SB(1, 1), b3 + hstep, voffB);
            PG8_WAIT_V(6); PG8_BAR; PG8_MMA(1, 1, At, B1); PG8_BAR;
            }
        }
        if constexpr (ALIGN_EPI) { if (wr == 0) PG8_BAR; }
        if constexpr (!Epi::AFTER_DRAIN) { E(acc, cur, wr, wc, fr, fq); S.done(cur); }
        if (!has_next) break;
#pragma unroll
        for (int a = 0; a < 2; ++a)
#pragma unroll
            for (int b = 0; b < 2; ++b)
#pragma unroll
                for (int m = 0; m < 4; ++m)
#pragma unroll
                    for (int n = 0; n < 2; ++n) acc[a][b][m][n] = (f32x4){0.f, 0.f, 0.f, 0.f};
        cur = nxt; cA = nA; cB = nB; ++ui;
        if constexpr (ALIGN_EPI) { if (wr == 1) PG8_BAR; }
    }
    PG8_WAIT_V(0);
    if constexpr (!ALIGN_EPI) { if (wr == 0) PG8_BAR; }
    PG8_BAR;
    if constexpr (Epi::AFTER_DRAIN) { E.fused(acc, cur, wr, wc, fr, fq, lds, wid, lane); S.done(cur); }
#undef PG8_SA
#undef PG8_SB
#undef PG8_STAGE
#undef PG8_LDA
#undef PG8_LDB
#undef PG8_MMA
#undef PG8_WAIT_V
#undef PG8_WAIT_L
#undef PG8_BAR
#undef PG8_SCHED
}
}

#ifndef MK_MULTI
#define MK_MULTI 0
#endif
constexpr int T = 8192, NBATCH = 2, M = NBATCH * T, D = 1024, FF = 4096, DIN = 2320, NIN = 2560, LDP = 2304, NMETA = 16, PMW = 1040;
constexpr int GQ = 0, GK = 256, GV = 512, GR = 1024, SQ = 1536, SK = 2048, SV = 2176;
constexpr float EPS = 1e-5f, LOG2E = 1.4426950408889634f;
constexpr size_t MiB = 1u << 20;
constexpr size_t WS_SSQ2 = 0, WS_SSQ3 = 65536, WS_PM = 131072, WS_ROPE = 262144;
constexpr size_t WS_WIN = 1 * MiB, WS_WO = 6 * MiB, WS_W1 = 8 * MiB, WS_W2 = 16 * MiB, WS_DC = 24 * MiB;
constexpr size_t WS_XN = 26 * MiB, WS_PROJ = 58 * MiB, WS_G = 130 * MiB, WS_DST = 146 * MiB, WS_ACT = 58 * MiB, WS_ST = 186 * MiB, WS_MIX = 202 * MiB, WS_END = 234 * MiB;
constexpr size_t WS_BAR = 25 * MiB, BAR_BYTES = 16384;
constexpr int LDS_BAR_OFF = 131072, LDS_BYTES = 131072 + 64;

typedef unsigned short bf16;
typedef short bf16x8 __attribute__((ext_vector_type(8)));
typedef float f32x4 __attribute__((ext_vector_type(4)));
typedef unsigned u32x4 __attribute__((ext_vector_type(4)));
typedef unsigned u32x2 __attribute__((ext_vector_type(2)));
using pg8::cvt_pk_bf16;

__device__ __forceinline__ float bf2f(unsigned short b) { return __uint_as_float((unsigned)b << 16); }
__device__ __forceinline__ float fexp(float x) { return __builtin_amdgcn_exp2f(x * LOG2E); }
__device__ __forceinline__ float wave_sum(float v) {
#pragma unroll
    for (int o = 1; o < 64; o <<= 1) v += __shfl_xor(v, o);
    return v;
}
__device__ __forceinline__ float logsig(float v) {
    const float e = __builtin_amdgcn_exp2f(-fabsf(v) * LOG2E);
    return fminf(v, 0.f) - __builtin_amdgcn_logf(1.f + e) * 0.6931471805599453f;
}
__device__ __forceinline__ u32x4 pack8(f32x4 a, f32x4 b) { u32x4 w; w.x = cvt_pk_bf16(a[0], a[1]); w.y = cvt_pk_bf16(a[2], a[3]); w.z = cvt_pk_bf16(b[0], b[1]); w.w = cvt_pk_bf16(b[2], b[3]); return w; }

struct Args { const float* in[13]; float* out; unsigned char* ws; int ph_lo, ph_hi; };
#define XB_TMO      128
#define XB_XCNT(j)  (256  + 64 * (j))
#define XB_XSUB(j)  (1280 + 64 * (j))
#define XB_XGEN(j)  (2304 + 64 * (j))
#define XB_TOP      3328
#define XB_TOPGEN   3392
#define XCD_BAR_WORDS 3456
#define XB_SPIN_CAP (1u << 18)
#define LAS __attribute__((address_space(3)))

__device__ __forceinline__ unsigned xb_ld(unsigned* p)              { return __hip_atomic_load(p, __ATOMIC_RELAXED, __HIP_MEMORY_SCOPE_AGENT); }
__device__ __forceinline__ unsigned xb_add(unsigned* p, unsigned v) { return __hip_atomic_fetch_add(p, v, __ATOMIC_RELAXED, __HIP_MEMORY_SCOPE_AGENT); }
__device__ __forceinline__ unsigned xb_xcc_id() { return (unsigned)__builtin_amdgcn_s_getreg((3 << 11) | 20) & 0xFu; }
#define XB_SPIN(cond, bar) do { unsigned _sp = 0; while (cond) { __builtin_amdgcn_s_sleep(1); \
    if ((++_sp & 255u) == 0u) { if (xb_ld(&(bar)[XB_TMO])) break; if (_sp > XB_SPIN_CAP) { atomicAdd(&(bar)[XB_TMO], 1u); break; } } } } while (0)

struct XcdBarrier {
    unsigned* bar; unsigned x;
    volatile LAS unsigned* st;
};

__device__ __forceinline__ XcdBarrier xcd_barrier_post(unsigned* bar, volatile LAS unsigned* st) {
    XcdBarrier b; b.bar = bar; b.x = xb_xcc_id(); b.st = st;
    if (threadIdx.x == 0) (void)xb_add(&bar[XB_XCNT(b.x)], 1u);
    return b;
}
__device__ __forceinline__ void xcd_barrier_complete(unsigned* bar, unsigned x, unsigned& nloc, unsigned& nx) {
    const unsigned G = gridDim.x * gridDim.y * gridDim.z;
    unsigned sum, cnt, mine, sp = 0u;
    for (;;) {
        sum = 0u; cnt = 0u; mine = 0u;
#pragma unroll
        for (unsigned j = 0; j < 16; ++j) { const unsigned c = xb_ld(&bar[XB_XCNT(j)]); sum += c; cnt += (c > 0u) ? 1u : 0u; mine = (j == x) ? c : mine; }
        if (sum == G) break;
        __builtin_amdgcn_s_sleep(1);
        if ((++sp & 255u) == 0u) { if (xb_ld(&bar[XB_TMO])) break; if (sp > XB_SPIN_CAP) { atomicAdd(&bar[XB_TMO], 1u); break; } }
    }
    nloc = mine > 0u ? mine : 1u; nx = cnt > 0u ? cnt : 1u;
}

__device__ __forceinline__ void xcd_barrier(const XcdBarrier& b) {
    asm volatile("s_waitcnt vmcnt(0)" ::: "memory");
    __syncthreads();
    if (threadIdx.x == 0) {
        unsigned* bar = b.bar;
        __builtin_amdgcn_s_waitcnt(0);
        unsigned nloc = b.st[0], nx = b.st[1];
        if (nloc == 0u) { xcd_barrier_complete(bar, b.x, nloc, nx); b.st[0] = nloc; b.st[1] = nx; }
        const unsigned old = xb_add(&bar[XB_XSUB(b.x)], 1u);
        const unsigned gen = old / nloc;
        if (old + 1u == (gen + 1u) * nloc) {
            __builtin_amdgcn_fence(__ATOMIC_RELEASE, "agent");
            asm volatile("s_waitcnt vmcnt(0)" ::: "memory");
            const unsigned og = xb_add(&bar[XB_TOP], 1u);
            const unsigned tg = og / nx;
            if (og + 1u == (tg + 1u) * nx) xb_add(&bar[XB_TOPGEN], 1u);
            else XB_SPIN(xb_ld(&bar[XB_TOPGEN]) == tg, bar);
            __builtin_amdgcn_fence(__ATOMIC_ACQUIRE, "agent");
            xb_add(&bar[XB_XGEN(b.x)], 1u);
            asm volatile("s_waitcnt vmcnt(0)" ::: "memory");
        } else {
            XB_SPIN(xb_ld(&bar[XB_XGEN(b.x)]) == gen, bar);
            __builtin_amdgcn_fence(__ATOMIC_ACQUIRE, "agent");
            asm volatile("s_waitcnt vmcnt(0)" ::: "memory");
        }
    }
    __syncthreads();
}


namespace pg8 {
struct EpiIn {
    static constexpr bool PERM = true, AFTER_DRAIN = false;
    bf16_t* P; float* G; const float* bgate; const float* rope;
    __device__ __forceinline__ void operator()(const f32x4 (&acc)[2][2][4][2], const Unit& u, int wr, int wc, int fr, int fq) const {
        const int row0 = u.pm * BM + wr * 64 + fr, pn = u.pn;
        if (pn == 9) {
            const int col0 = wc * 32 + 8 * fq;
            f32x4 bv[2][2];
#pragma unroll
            for (int bj = 0; bj < 2; ++bj)
#pragma unroll
                for (int n = 0; n < 2; ++n) bv[bj][n] = *(const f32x4*)(bgate + col0 + bj * HALF + 4 * n);
#pragma unroll
            for (int ai = 0; ai < 2; ++ai)
#pragma unroll
                for (int m = 0; m < 4; ++m) { float* rowp = G + (size_t)(row0 + ai * HALF + m * 16) * 256 + col0;
#pragma unroll
                    for (int bj = 0; bj < 2; ++bj)
#pragma unroll
                        for (int n = 0; n < 2; ++n) { f32x4 v = acc[ai][bj][m][n] + bv[bj][n]; f32x4 g;
#pragma unroll
                            for (int e = 0; e < 4; ++e) g[e] = logsig(v[e]) * 0.0625f;
                            *(f32x4*)(rowp + bj * HALF + 4 * n) = g; } }
        } else {
            const bool rope_tile = (pn >= 6) && ((wc & 1) == 0);
            const float sc = (pn == 0 || pn == 6 || pn == 7) ? 0.125f : 1.f;
            const int col0 = pn * BM + wc * 32 + 8 * fq;
            const float sgn = (fq == 0) ? -1.f : 1.f; const bool app = fq < 2;
#pragma unroll
            for (int ai = 0; ai < 2; ++ai)
#pragma unroll
                for (int m = 0; m < 4; ++m) { const int row = row0 + ai * HALF + m * 16; bf16_t* rowp = P + (size_t)row * 2304 + col0;
                    f32x4 c0 = {1.f, 1.f, 1.f, 1.f}, c1 = c0, s0 = {0.f, 0.f, 0.f, 0.f}, s1 = s0;
                    if (rope_tile) { const float* rp = rope + (size_t)(16 + (row & 8191)) * 16; c0 = *(const f32x4*)rp; c1 = *(const f32x4*)(rp + 4); s0 = *(const f32x4*)(rp + 8); s1 = *(const f32x4*)(rp + 12); }
#pragma unroll
                    for (int bj = 0; bj < 2; ++bj) { f32x4 v0 = acc[ai][bj][m][0], v1 = acc[ai][bj][m][1];
                        if (rope_tile && (pn != 8 || bj == 0)) {
                            f32x4 p0, p1;
#pragma unroll
                            for (int e = 0; e < 4; ++e) { p0[e] = __shfl_xor(v0[e], 16); p1[e] = __shfl_xor(v1[e], 16); }
                            if (app) { v0 = v0 * c0 + (p0 * s0) * sgn; v1 = v1 * c1 + (p1 * s1) * sgn; }
                        }
                        v0 = v0 * sc; v1 = v1 * sc;
                        u32x4 w; w.x = cvt_pk_bf16(v0[0], v0[1]); w.y = cvt_pk_bf16(v0[2], v0[3]); w.z = cvt_pk_bf16(v1[0], v1[1]); w.w = cvt_pk_bf16(v1[2], v1[3]);
                        *(u32x4*)(rowp + bj * HALF) = w; } }
        }
    }
};
struct EpiRes {
    static constexpr bool PERM = true, AFTER_DRAIN = false;
    const float* base; float* out; bf16_t* hb; float* ssq;
    __device__ __forceinline__ void operator()(const f32x4 (&acc)[2][2][4][2], const Unit& u, int wr, int wc, int fr, int fq) const {
        const int row0 = u.pm * BM + wr * 64 + fr, col0 = u.pn * BM + wc * 32 + 8 * fq;
#pragma unroll
        for (int ai = 0; ai < 2; ++ai)
#pragma unroll
            for (int m = 0; m < 4; ++m) { const int row = row0 + ai * HALF + m * 16; const size_t off = (size_t)row * 1024 + col0; float ss = 0.f;
#pragma unroll
                for (int bj = 0; bj < 2; ++bj) { const f32x4 x0 = *(const f32x4*)(base + off + bj * HALF), x1 = *(const f32x4*)(base + off + bj * HALF + 4);
                    const f32x4 h0 = acc[ai][bj][m][0] + x0, h1 = acc[ai][bj][m][1] + x1;
                    *(f32x4*)(out + off + bj * HALF) = h0; *(f32x4*)(out + off + bj * HALF + 4) = h1;
                    if (hb) { u32x4 w; w.x = cvt_pk_bf16(h0[0], h0[1]); w.y = cvt_pk_bf16(h0[2], h0[3]); w.z = cvt_pk_bf16(h1[0], h1[1]); w.w = cvt_pk_bf16(h1[2], h1[3]); *(u32x4*)(hb + off + bj * HALF) = w; }
                    ss += (h0[0] * h0[0] + h0[1] * h0[1]) + (h0[2] * h0[2] + h0[3] * h0[3]) + (h1[0] * h1[0] + h1[1] * h1[1]) + (h1[2] * h1[2] + h1[3] * h1[3]); }
                ss += __shfl_xor(ss, 16); ss += __shfl_xor(ss, 32);
                if (fq == 0) atomicAdd(ssq + row, ss); }
    }
};
struct EpiFF1 {
    static constexpr bool PERM = true, AFTER_DRAIN = false;
    bf16_t* O; const float* ssq;
    __device__ __forceinline__ void operator()(const f32x4 (&acc)[2][2][4][2], const Unit& u, int wr, int wc, int fr, int fq) const {
        const int row0 = u.pm * BM + wr * 64 + fr, col0 = u.pn * BM + wc * 32 + 8 * fq;
#pragma unroll
        for (int ai = 0; ai < 2; ++ai)
#pragma unroll
            for (int m = 0; m < 4; ++m) { const int row = row0 + ai * HALF + m * 16; const float rs = __builtin_amdgcn_rsqf(ssq[row] * (1.f / 1024.f) + 1e-5f);
                bf16_t* rowp = O + (size_t)row * 4096 + col0;
#pragma unroll
                for (int bj = 0; bj < 2; ++bj) { f32x4 v0 = acc[ai][bj][m][0] * rs, v1 = acc[ai][bj][m][1] * rs;
#pragma unroll
                    for (int e = 0; e < 4; ++e) { const float a = fmaxf(v0[e], 0.f), b = fmaxf(v1[e], 0.f); v0[e] = a * a; v1[e] = b * b; }
                    u32x4 w; w.x = cvt_pk_bf16(v0[0], v0[1]); w.y = cvt_pk_bf16(v0[2], v0[3]); w.z = cvt_pk_bf16(v1[0], v1[1]); w.w = cvt_pk_bf16(v1[2], v1[3]);
                    *(u32x4*)(rowp + bj * HALF) = w; } }
    }
};
}

__device__ __forceinline__ void p0_transpose_item(const float* W, int ldw, int K, const float* scale, bf16* WT, int src_col0, int dst_row0, int k0, float* scr, int lane) {
#pragma unroll 8
    for (int i = 0; i < 32; ++i) { const int kk = 2 * i + (lane >> 5); float v = W[(size_t)(k0 + kk) * ldw + src_col0 + (lane & 31)]; if (scale) v *= scale[k0 + kk]; scr[kk * 33 + (lane & 31)] = v; }
    asm volatile("s_waitcnt lgkmcnt(0)" ::: "memory");
    const int c = lane & 7;
#pragma unroll
    for (int j = 0; j < 4; ++j) { const int n = (lane >> 3) + 8 * j; const float* s = scr + (8 * c) * 33 + n;
        u32x4 o; o.x = cvt_pk_bf16(s[0 * 33], s[1 * 33]); o.y = cvt_pk_bf16(s[2 * 33], s[3 * 33]); o.z = cvt_pk_bf16(s[4 * 33], s[5 * 33]); o.w = cvt_pk_bf16(s[6 * 33], s[7 * 33]);
        *(u32x4*)(WT + (size_t)(dst_row0 + n) * K + k0 + 8 * c) = o; }
    asm volatile("s_waitcnt lgkmcnt(0)" ::: "memory");
}

__device__ __forceinline__ void p0_prologue(const Args& a, unsigned char* lds) {
    const int tid = threadIdx.x, lane = tid & 63, wave = tid >> 6, G = gridDim.x, blk = blockIdx.x;
    unsigned char* ws = a.ws;
    const float* x = a.in[0]; const float* meta = a.in[1]; const float* nmw = a.in[2]; const float* w_in = a.in[3]; const float* wgu = a.in[4];
    const float* w_out = a.in[8]; const float* nfw = a.in[9]; const float* w1 = a.in[10]; const float* w2 = a.in[11];
    bf16* WIN = (bf16*)(ws + WS_WIN); bf16* WO = (bf16*)(ws + WS_WO); bf16* W1 = (bf16*)(ws + WS_W1); bf16* W2 = (bf16*)(ws + WS_W2); bf16* XN = (bf16*)(ws + WS_XN);
    const int gtid = blk * 512 + tid, NT = G * 512;
    for (int e = gtid; e < 32768; e += NT) ((float*)(ws + WS_SSQ2))[e] = 0.f;
    for (int e = gtid; e < (T + NMETA) * 8; e += NT) { const int pos = e >> 3, i = e & 7;
        const float inv = exp2f(-(float)i * (18.931568569324174f * 0.125f)); const float ang = (float)pos * inv;
        double r = (double)ang * 0.15915494309189535; r -= floor(r); const float rf = (float)r;
        float* rp = (float*)(ws + WS_ROPE) + (size_t)pos * 16; rp[i] = __builtin_amdgcn_cosf(rf); rp[8 + i] = __builtin_amdgcn_sinf(rf); }
    if (blk < 17) {
        float* um = (float*)lds; float* red = (float*)(lds + 65536);
        for (int r = 2 * wave; r < 2 * wave + 2; ++r) { const f32x4* xr = (const f32x4*)(meta + (size_t)r * D) + lane; f32x4 v[4]; float s = 0.f;
#pragma unroll
            for (int j = 0; j < 4; ++j) { v[j] = xr[64 * j]; s += (v[j][0] * v[j][0] + v[j][1] * v[j][1]) + (v[j][2] * v[j][2] + v[j][3] * v[j][3]); }
            const float rstd = 1.0f / sqrtf(wave_sum(s) * (1.f / D) + EPS);
#pragma unroll
            for (int j = 0; j < 4; ++j) { const f32x4 w = ((const f32x4*)nmw)[lane + 64 * j]; ((f32x4*)(um + r * D))[lane + 64 * j] = v[j] * rstd * w; } }
        __syncthreads();
        const int col = tid & 63, ks = tid >> 6, j = 64 * blk + col; const bool valid = j < PMW;
        const int src = j < 768 ? 256 + j : (j < 784 ? 1536 + (j - 768) : 2064 + (j - 784));
        float acc[16];
#pragma unroll
        for (int r = 0; r < 16; ++r) acc[r] = 0.f;
        if (valid) for (int k = 128 * ks; k < 128 * ks + 128; k += 4) {
            const float w0 = w_in[(size_t)k * DIN + src], w1_ = w_in[(size_t)(k + 1) * DIN + src], w2_ = w_in[(size_t)(k + 2) * DIN + src], w3 = w_in[(size_t)(k + 3) * DIN + src];
#pragma unroll
            for (int r = 0; r < 16; ++r) { const f32x4 uv = *(const f32x4*)(um + r * D + k); acc[r] += (uv[0] * w0 + uv[1] * w1_) + (uv[2] * w2_ + uv[3] * w3); } }
#pragma unroll
        for (int r = 0; r < 16; ++r) red[(ks * 16 + r) * 64 + col] = acc[r];
        __syncthreads();
        for (int o = tid; o < 1024; o += 512) { const int r = o >> 6, c = o & 63; float s = 0.f;
#pragma unroll
            for (int k2 = 0; k2 < 8; ++k2) s += red[(k2 * 16 + r) * 64 + c];
            if (64 * blk + c < PMW) ((float*)(ws + WS_PM))[r * PMW + 64 * blk + c] = s; }
        __syncthreads();
    }
    for (int e = gtid; e < 256 * 128; e += NT) { const int n = e >> 7, k8 = e & 127; float wg[16];
#pragma unroll
        for (int r = 0; r < 16; ++r) wg[r] = wgu[r * 256 + n];
        float o[8];
#pragma unroll
        for (int kk = 0; kk < 8; ++kk) { const int k = 8 * k8 + kk; const f32x4* p = (const f32x4*)(w_in + (size_t)k * DIN + 1536); float s = 0.f;
#pragma unroll
            for (int q = 0; q < 4; ++q) { const f32x4 v = p[q]; s += (v[0] * wg[4 * q] + v[1] * wg[4 * q + 1]) + (v[2] * wg[4 * q + 2] + v[3] * wg[4 * q + 3]); }
            o[kk] = s * nmw[k]; }
        u32x4 w; w.x = cvt_pk_bf16(o[0], o[1]); w.y = cvt_pk_bf16(o[2], o[3]); w.z = cvt_pk_bf16(o[4], o[5]); w.w = cvt_pk_bf16(o[6], o[7]);
        *(u32x4*)(WIN + (size_t)(2304 + n) * D + 8 * k8) = w; }
    float* scr = (float*)lds + wave * 2112;
    const int gw = blk * 8 + wave, NGW = G * 8;
    constexpr int I_IN = 16 * 72, I_O = 16 * 32, I_1 = 16 * 128, I_2 = 64 * 32, NITEMS = I_IN + I_O + I_1 + I_2;
    for (int it = gw; it < NITEMS; it += NGW) { int r = it;
        if (r < I_IN) { const int kb = r / 72, nb = r % 72, dr = 32 * nb; p0_transpose_item(w_in, DIN, D, nmw, WIN, dr < 1536 ? dr : dr + 16, dr, 64 * kb, scr, lane); continue; } r -= I_IN;
        if (r < I_O) { const int kb = r / 32, nb = r % 32; p0_transpose_item(w_out, D, D, nullptr, WO, 32 * nb, 32 * nb, 64 * kb, scr, lane); continue; } r -= I_O;
        if (r < I_1) { const int kb = r / 128, nb = r % 128; p0_transpose_item(w1, FF, D, nfw, W1, 32 * nb, 32 * nb, 64 * kb, scr, lane); continue; } r -= I_1;
        { const int kb = r / 32, nb = r % 32; p0_transpose_item(w2, D, FF, nullptr, W2, 32 * nb, 32 * nb, 64 * kb, scr, lane); } }
    for (int m = gw; m < M; m += NGW) { const f32x4* xr = (const f32x4*)(x + (size_t)m * D) + lane; f32x4 v[4]; float s = 0.f;
#pragma unroll
        for (int j = 0; j < 4; ++j) { v[j] = xr[64 * j]; s += (v[j][0] * v[j][0] + v[j][1] * v[j][1]) + (v[j][2] * v[j][2] + v[j][3] * v[j][3]); }
        const float rstd = 1.0f / sqrtf(wave_sum(s) * (1.f / D) + EPS);
        u32x2* o8 = (u32x2*)(XN + (size_t)m * D) + lane;
#pragma unroll
        for (int j = 0; j < 4; ++j) { u32x2 w; w.x = cvt_pk_bf16(v[j][0] * rstd, v[j][1] * rstd); w.y = cvt_pk_bf16(v[j][2] * rstd, v[j][3] * rstd); o8[64 * j] = w; } }
}

__device__ __forceinline__ void swa_phase(const Args& a, unsigned char* lds) {
    const int tid = threadIdx.x, lane = tid & 63, w = tid >> 6, fr = lane & 15, fq = lane >> 4;
    unsigned char* ws = a.ws;
    const bf16* P = (const bf16*)(ws + WS_PROJ); const float* PM = (const float*)(ws + WS_PM); const float* rope = (const float*)(ws + WS_ROPE);
    bf16* MIX = (bf16*)(ws + WS_MIX); const float* sinks = a.in[7];
    bf16* KS = (bf16*)lds;
    bf16* VT = (bf16*)(lds + 39168);
    for (int unit = blockIdx.x; unit < 256; unit += gridDim.x) {
        const int b = unit >> 7, n = (unit >> 1) & 63, kv = unit & 1;
        const size_t tok0 = (size_t)b * T + 128 * n;
#pragma unroll
        for (int i = 0; i < 4; ++i) { const int c = tid + 512 * i, jj = c >> 3, dc = c & 7; u32x4 v = {0u, 0u, 0u, 0u};
            if (n > 0 || jj >= 128) v = *(const u32x4*)(P + ((long)tok0 - 128 + jj) * LDP + SK + 64 * kv + 8 * dc);
            *(u32x4*)(KS + (16 + jj) * 72 + 8 * dc) = v; }
        if (tid < 128) { const int t = tid >> 3, dc = tid & 7; const float* src = PM + t * PMW + 784 + 64 * kv;
            f32x4 x0 = *(const f32x4*)(src + 8 * dc), x1 = *(const f32x4*)(src + 8 * dc + 4);
            if (dc < 2) { const f32x4 p0 = *(const f32x4*)(src + 8 * (1 - dc)), p1 = *(const f32x4*)(src + 8 * (1 - dc) + 4); const float* rp = rope + t * 16;
                const f32x4 c0 = *(const f32x4*)rp, c1 = *(const f32x4*)(rp + 4), s0 = *(const f32x4*)(rp + 8), s1 = *(const f32x4*)(rp + 12); const float sgn = dc == 0 ? -1.f : 1.f;
                x0 = x0 * c0 + (p0 * s0) * sgn; x1 = x1 * c1 + (p1 * s1) * sgn; }
            *(u32x4*)(KS + t * 72 + 8 * dc) = pack8(x0, x1);
        } else if (tid < 256) { const int d = tid & 63, hf = (tid >> 6) & 1; const float* src = PM + (8 * hf) * PMW + 912 + 64 * kv + d; float v[8];
#pragma unroll
            for (int i = 0; i < 8; ++i) v[i] = src[i * PMW];
            u32x4 wv; wv.x = cvt_pk_bf16(v[0], v[1]); wv.y = cvt_pk_bf16(v[2], v[3]); wv.z = cvt_pk_bf16(v[4], v[5]); wv.w = cvt_pk_bf16(v[6], v[7]);
            *(u32x4*)(VT + d * 280 + 8 * hf) = wv; }
        { const int d = tid & 63, sg = tid >> 6; unsigned short vr[32];
            const bool ok = (n > 0 || sg >= 4); const bf16* vp = P + ((long)tok0 - 128 + 32 * sg) * LDP + SV + 64 * kv + d;
#pragma unroll
            for (int i = 0; i < 32; ++i) vr[i] = ok ? vp[(long)i * LDP] : (unsigned short)0;
#pragma unroll
            for (int q = 0; q < 4; ++q) { u32x4 wv; wv.x = vr[8 * q] | ((unsigned)vr[8 * q + 1] << 16); wv.y = vr[8 * q + 2] | ((unsigned)vr[8 * q + 3] << 16); wv.z = vr[8 * q + 4] | ((unsigned)vr[8 * q + 5] << 16); wv.w = vr[8 * q + 6] | ((unsigned)vr[8 * q + 7] << 16);
                *(u32x4*)(VT + d * 280 + 16 + 32 * sg + 8 * q) = wv; } }
        __syncthreads();
        const int gh = w >> 1, th = w & 1, qh = 4 * kv + gh; const float sink2 = sinks[qh] * LOG2E;
        for (int it = 0; it < 4; ++it) {
            const int r0 = 64 * th + 16 * it; const size_t qrow = tok0 + r0 + fr;
            bf16x8 qf[2];
#pragma unroll
            for (int kk = 0; kk < 2; ++kk) qf[kk] = *(const bf16x8*)(P + qrow * LDP + SQ + 64 * qh + 32 * kk + 8 * fq);
            f32x4 s[10];
#pragma unroll
            for (int tl = 0; tl < 10; ++tl) { const int krow0 = tl == 0 ? 0 : 16 + r0 + 16 * (tl - 1); f32x4 acc = {0.f, 0.f, 0.f, 0.f};
#pragma unroll
                for (int kk = 0; kk < 2; ++kk) { const bf16x8 kf = *(const bf16x8*)(KS + (krow0 + fr) * 72 + 32 * kk + 8 * fq); acc = __builtin_amdgcn_mfma_f32_16x16x32_bf16(kf, qf[kk], acc, 0, 0, 0); }
                s[tl] = acc; }
            float mx = sink2; const int rr = r0 + fr;
#pragma unroll
            for (int tl = 0; tl < 10; ++tl)
#pragma unroll
                for (int e = 0; e < 4; ++e) { float v = s[tl][e] * LOG2E;
                    if (tl > 0) { const int jj = r0 + 16 * (tl - 1) + 4 * fq + e, dist = 128 + rr - jj; const bool ok = dist >= 0 && dist < 128 && (n > 0 || jj >= 128); v = ok ? v : -INFINITY; }
                    s[tl][e] = v; mx = fmaxf(mx, v); }
            mx = fmaxf(mx, __shfl_xor(mx, 16)); mx = fmaxf(mx, __shfl_xor(mx, 32));
            float l = 0.f;
#pragma unroll
            for (int tl = 0; tl < 10; ++tl)
#pragma unroll
                for (int e = 0; e < 4; ++e) { const float p = __builtin_amdgcn_exp2f(s[tl][e] - mx); s[tl][e] = p; l += p; }
            l += __shfl_xor(l, 16); l += __shfl_xor(l, 32); l += __builtin_amdgcn_exp2f(sink2 - mx);
            const float rl = 1.0f / l;
            f32x4 o[4];
#pragma unroll
            for (int dt = 0; dt < 4; ++dt) o[dt] = (f32x4){0.f, 0.f, 0.f, 0.f};
#pragma unroll
            for (int pr = 0; pr < 5; ++pr) { const int ta = 2 * pr, tb = 2 * pr + 1;
                const int ka = ta == 0 ? 0 : 16 + r0 + 16 * (ta - 1), kb = 16 + r0 + 16 * (tb - 1);
                const u32x4 pw = pack8(s[ta], s[tb]); const bf16x8 pf = __builtin_bit_cast(bf16x8, pw);
#pragma unroll
                for (int dt = 0; dt < 4; ++dt) { const bf16* vrow = VT + (16 * dt + fr) * 280 + 4 * fq;
                    const u32x2 va = *(const u32x2*)(vrow + ka), vb = *(const u32x2*)(vrow + kb); const u32x4 vw = {va.x, va.y, vb.x, vb.y};
                    o[dt] = __builtin_amdgcn_mfma_f32_16x16x32_bf16(__builtin_bit_cast(bf16x8, vw), pf, o[dt], 0, 0, 0); } }
#pragma unroll
            for (int dt = 0; dt < 4; ++dt) { u32x2 wv; wv.x = cvt_pk_bf16(o[dt][0] * rl, o[dt][1] * rl); wv.y = cvt_pk_bf16(o[dt][2] * rl, o[dt][3] * rl);
                *(u32x2*)(MIX + qrow * D + 512 + 64 * qh + 16 * dt + 4 * fq) = wv; }
        }
        __syncthreads();
    }
}

__device__ __forceinline__ void gla_local_phase(const Args& a, unsigned char* lds) {
    const int tid = threadIdx.x, hb = tid >> 8, t256 = tid & 255, lane = tid & 63, w4 = (tid >> 6) & 3, fr = lane & 15, fq = lane >> 4;
    unsigned char* ws = a.ws;
    const bf16* P = (const bf16*)(ws + WS_PROJ); const float* G = (const float*)(ws + WS_G); float* DST = (float*)(ws + WS_DST); float* DC = (float*)(ws + WS_DC);
    unsigned char* base = lds + hb * 28672;
    bf16* KT = (bf16*)base; bf16* VT = (bf16*)(base + 9216); float* tot = (float*)(base + 27648);
    for (int p = blockIdx.x; p < 512; p += gridDim.x) {
        const int v = 2 * p + hb, h = v & 3, c = (v >> 2) & 127, b = v >> 9; const size_t row0 = (size_t)b * T + 64 * c; const int uidx = (b * 4 + h) * 128 + c;
        const int i = t256 & 63, seg = t256 >> 6;
        float bc[16];
        { const float* gp = G + (row0 + 16 * seg) * 256 + 64 * h + i; float run = 0.f;
#pragma unroll
            for (int tt = 0; tt < 16; ++tt) { run += gp[tt * 256]; bc[tt] = run; } }
        tot[seg * 64 + i] = bc[15];
        unsigned short kr[16];
        { const bf16* kp = P + (row0 + 16 * seg) * LDP + GK + 64 * h + i;
#pragma unroll
            for (int tt = 0; tt < 16; ++tt) kr[tt] = kp[(size_t)tt * LDP]; }
        const int j = t256 & 127, sg = t256 >> 7; unsigned short vr[32];
        { const bf16* vp = P + (row0 + 32 * sg) * LDP + GV + 128 * h + j;
#pragma unroll
            for (int tt = 0; tt < 32; ++tt) vr[tt] = vp[(size_t)tt * LDP]; }
        __syncthreads();
        float off = 0.f, total = 0.f;
#pragma unroll
        for (int s = 0; s < 4; ++s) { const float xv = tot[s * 64 + i]; total += xv; if (s < seg) off += xv; }
        float kt[16];
#pragma unroll
        for (int tt = 0; tt < 16; ++tt) kt[tt] = bf2f(kr[tt]) * fexp(total - (bc[tt] + off));
        { u32x4 w0, w1; w0.x = cvt_pk_bf16(kt[0], kt[1]); w0.y = cvt_pk_bf16(kt[2], kt[3]); w0.z = cvt_pk_bf16(kt[4], kt[5]); w0.w = cvt_pk_bf16(kt[6], kt[7]);
            w1.x = cvt_pk_bf16(kt[8], kt[9]); w1.y = cvt_pk_bf16(kt[10], kt[11]); w1.z = cvt_pk_bf16(kt[12], kt[13]); w1.w = cvt_pk_bf16(kt[14], kt[15]);
            *(u32x4*)(KT + i * 72 + 16 * seg) = w0; *(u32x4*)(KT + i * 72 + 16 * seg + 8) = w1; }
        if (seg == 3) DC[uidx * 64 + i] = fexp(total);
#pragma unroll
        for (int q = 0; q < 4; ++q) { u32x4 wv; wv.x = vr[8 * q] | ((unsigned)vr[8 * q + 1] << 16); wv.y = vr[8 * q + 2] | ((unsigned)vr[8 * q + 3] << 16); wv.z = vr[8 * q + 4] | ((unsigned)vr[8 * q + 5] << 16); wv.w = vr[8 * q + 6] | ((unsigned)vr[8 * q + 7] << 16);
            *(u32x4*)(VT + j * 72 + 32 * sg + 8 * q) = wv; }
        __syncthreads();
        f32x4 acc[8];
#pragma unroll
        for (int jt = 0; jt < 8; ++jt) acc[jt] = (f32x4){0.f, 0.f, 0.f, 0.f};
#pragma unroll
        for (int kk = 0; kk < 2; ++kk) { const bf16x8 af = *(const bf16x8*)(KT + (16 * w4 + fr) * 72 + 32 * kk + 8 * fq);
#pragma unroll
            for (int jt = 0; jt < 8; ++jt) { const bf16x8 bfr = *(const bf16x8*)(VT + (16 * jt + fr) * 72 + 32 * kk + 8 * fq); acc[jt] = __builtin_amdgcn_mfma_f32_16x16x32_bf16(af, bfr, acc[jt], 0, 0, 0); } }
        float* dst = DST + (size_t)uidx * 8192;
#pragma unroll
        for (int jt = 0; jt < 8; ++jt) *(f32x4*)(dst + (16 * jt + fr) * 64 + 16 * w4 + 4 * fq) = acc[jt];
        __syncthreads();
    }
}

__device__ __forceinline__ void gla_scan_phase(const Args& a) {
    const int tid = threadIdx.x; if (tid >= 256) return;
    unsigned char* ws = a.ws;
    const float* PM = (const float*)(ws + WS_PM); const float* DST = (const float*)(ws + WS_DST); const float* DC = (const float*)(ws + WS_DC); bf16* ST = (bf16*)(ws + WS_ST);
    const float* wgu = a.in[4]; const float* bgate = a.in[5];
    for (int ge = blockIdx.x * 256 + tid; ge < 65536; ge += gridDim.x * 256) {
        const int bh = ge >> 13, e = ge & 8191, i = e & 63, j = e >> 6, h = bh & 3;
        float S = 0.f;
        { float bc[16]; float run = 0.f; const int gi = 64 * h + i; const float bg = bgate[gi]; float wg[16];
#pragma unroll
            for (int r = 0; r < 16; ++r) wg[r] = wgu[r * 256 + gi];
#pragma unroll
            for (int t = 0; t < 16; ++t) { float lg = bg;
#pragma unroll
                for (int r = 0; r < 16; ++r) lg += PM[t * PMW + 768 + r] * wg[r];
                run += logsig(lg) * 0.0625f; bc[t] = run; }
#pragma unroll
            for (int t = 0; t < 16; ++t) S += PM[t * PMW + gi] * fexp(run - bc[t]) * PM[t * PMW + 256 + 128 * h + j]; }
        const size_t ub = (size_t)bh * 128;
        for (int c0 = 0; c0 < 128; c0 += 8) { float ds[8], dc[8];
#pragma unroll
            for (int q = 0; q < 8; ++q) { ds[q] = DST[(ub + c0 + q) * 8192 + e]; dc[q] = DC[(ub + c0 + q) * 64 + i]; }
#pragma unroll
            for (int q = 0; q < 8; ++q) { ST[(ub + c0 + q) * 8192 + e] = (bf16)(cvt_pk_bf16(S, 0.f) & 0xffffu); S = dc[q] * S + ds[q]; } }
    }
}

__device__ __forceinline__ void gla_out_phase(const Args& a, unsigned char* lds) {
    const int tid = threadIdx.x, hb = tid >> 8, t256 = tid & 255, lane = tid & 63, w4 = (tid >> 6) & 3, fr = lane & 15, fq = lane >> 4;
    unsigned char* ws = a.ws;
    const bf16* P = (const bf16*)(ws + WS_PROJ); const float* G = (const float*)(ws + WS_G); const bf16* ST = (const bf16*)(ws + WS_ST); bf16* MIX = (bf16*)(ws + WS_MIX);
    const float* gnw = a.in[6];
    unsigned char* base = lds + hb * 47104;
    bf16* QS = (bf16*)base; bf16* KS = (bf16*)(base + 9216); bf16* VT = (bf16*)(base + 18432); bf16* AS = (bf16*)(base + 36864); float* tot = (float*)(base + 46080);
    for (int p = blockIdx.x; p < 512; p += gridDim.x) {
        const int v = 2 * p + hb, h = v & 3, c = (v >> 2) & 127, b = v >> 9; const size_t row0 = (size_t)b * T + 64 * c; const int uidx = (b * 4 + h) * 128 + c;
        bf16x8 sf[8][2];
        { const bf16* su = ST + (size_t)uidx * 8192;
#pragma unroll
            for (int jt = 0; jt < 8; ++jt)
#pragma unroll
                for (int kk = 0; kk < 2; ++kk) sf[jt][kk] = *(const bf16x8*)(su + (16 * jt + fr) * 64 + 32 * kk + 8 * fq); }
        const int i = t256 & 63, seg = t256 >> 6;
        float bc[16];
        { const float* gp = G + (row0 + 16 * seg) * 256 + 64 * h + i; float run = 0.f;
#pragma unroll
            for (int tt = 0; tt < 16; ++tt) { run += gp[tt * 256]; bc[tt] = run; } }
        tot[seg * 64 + i] = bc[15];
        unsigned short qr[16], kr[16];
        { const bf16* qp = P + (row0 + 16 * seg) * LDP + GQ + 64 * h + i;
#pragma unroll
            for (int tt = 0; tt < 16; ++tt) { qr[tt] = qp[(size_t)tt * LDP]; kr[tt] = qp[(size_t)tt * LDP + (GK - GQ)]; } }
        const int j = t256 & 127, sg = t256 >> 7; unsigned short vr[32];
        { const bf16* vp = P + (row0 + 32 * sg) * LDP + GV + 128 * h + j;
#pragma unroll
            for (int tt = 0; tt < 32; ++tt) vr[tt] = vp[(size_t)tt * LDP]; }
        __syncthreads();
        float off = 0.f;
#pragma unroll
        for (int s = 0; s < 3; ++s) { const float xv = tot[s * 64 + i]; if (s < seg) off += xv; }
#pragma unroll
        for (int tt = 0; tt < 16; ++tt) { const float bb = bc[tt] + off; const float qv = bf2f(qr[tt]) * fexp(bb), kv = bf2f(kr[tt]) * fexp(-bb);
            const unsigned w = cvt_pk_bf16(qv, kv); QS[(16 * seg + tt) * 72 + i] = (bf16)(w & 0xffffu); KS[(16 * seg + tt) * 72 + i] = (bf16)(w >> 16); }
#pragma unroll
        for (int q = 0; q < 4; ++q) { u32x4 wv; wv.x = vr[8 * q] | ((unsigned)vr[8 * q + 1] << 16); wv.y = vr[8 * q + 2] | ((unsigned)vr[8 * q + 3] << 16); wv.z = vr[8 * q + 4] | ((unsigned)vr[8 * q + 5] << 16); wv.w = vr[8 * q + 6] | ((unsigned)vr[8 * q + 7] << 16);
            *(u32x4*)(VT + j * 72 + 32 * sg + 8 * q) = wv; }
        __syncthreads();
        bf16x8 qa[2];
#pragma unroll
        for (int kk = 0; kk < 2; ++kk) qa[kk] = *(const bf16x8*)(QS + (16 * w4 + fr) * 72 + 32 * kk + 8 * fq);
#pragma unroll
        for (int st = 0; st < 4; ++st) { f32x4 acc = {0.f, 0.f, 0.f, 0.f};
#pragma unroll
            for (int kk = 0; kk < 2; ++kk) { const bf16x8 kb = *(const bf16x8*)(KS + (16 * st + fr) * 72 + 32 * kk + 8 * fq); acc = __builtin_amdgcn_mfma_f32_16x16x32_bf16(qa[kk], kb, acc, 0, 0, 0); }
#pragma unroll
            for (int r = 0; r < 4; ++r) { const int t = 16 * w4 + 4 * fq + r, s = 16 * st + fr; const float val = s <= t ? acc[r] : 0.f; AS[t * 72 + s] = (bf16)(cvt_pk_bf16(val, 0.f) & 0xffffu); } }
        __syncthreads();
        f32x4 o[8];
#pragma unroll
        for (int jt = 0; jt < 8; ++jt) o[jt] = (f32x4){0.f, 0.f, 0.f, 0.f};
#pragma unroll
        for (int kk = 0; kk < 2; ++kk) { const bf16x8 a1 = *(const bf16x8*)(AS + (16 * w4 + fr) * 72 + 32 * kk + 8 * fq);
#pragma unroll
            for (int jt = 0; jt < 8; ++jt) { const bf16x8 vb = *(const bf16x8*)(VT + (16 * jt + fr) * 72 + 32 * kk + 8 * fq);
                o[jt] = __builtin_amdgcn_mfma_f32_16x16x32_bf16(a1, vb, o[jt], 0, 0, 0); o[jt] = __builtin_amdgcn_mfma_f32_16x16x32_bf16(qa[kk], sf[jt][kk], o[jt], 0, 0, 0); } }
        float rs[4];
#pragma unroll
        for (int r = 0; r < 4; ++r) { float ss = 0.f;
#pragma unroll
            for (int jt = 0; jt < 8; ++jt) ss += o[jt][r] * o[jt][r];
            ss += __shfl_xor(ss, 1); ss += __shfl_xor(ss, 2); ss += __shfl_xor(ss, 4); ss += __shfl_xor(ss, 8);
            rs[r] = 1.0f / sqrtf(ss * (1.f / 128.f) + EPS); }
#pragma unroll
        for (int jt = 0; jt < 8; ++jt) { const int jc = 16 * jt + fr; const float gw_ = gnw[jc];
#pragma unroll
            for (int r = 0; r < 4; ++r) { const size_t row = row0 + 16 * w4 + 4 * fq + r; const float rg = bf2f(P[row * LDP + GR + 128 * h + jc]);
                const float sl = rg / (1.f + fexp(-rg)); const float val = o[jt][r] * rs[r] * gw_ * sl;
                MIX[row * D + 128 * h + jc] = (bf16)(cvt_pk_bf16(val, 0.f) & 0xffffu); } }
        __syncthreads();
    }
}

__device__ __forceinline__ void final_norm_phase(const Args& a) {
    const int tid = threadIdx.x, lane = tid & 63, wave = tid >> 6; const float* ssq = (const float*)(a.ws + WS_SSQ3); const float* fw = a.in[12];
    f32x4 w[4];
#pragma unroll
    for (int j = 0; j < 4; ++j) w[j] = ((const f32x4*)fw)[lane + 64 * j];
    for (int m = blockIdx.x * 8 + wave; m < M; m += gridDim.x * 8) { f32x4* xr = (f32x4*)(a.out + (size_t)m * D) + lane; const float rstd = 1.0f / sqrtf(ssq[m] * (1.f / D) + EPS);
#pragma unroll
        for (int j = 0; j < 4; ++j) xr[64 * j] = xr[64 * j] * rstd * w[j]; }
}

__global__ void __launch_bounds__(512, 2) hybrid_fwd(Args a) {
    extern __shared__ __attribute__((aligned(16))) unsigned char lds[];
    PG8_LAS unsigned char* lds3 = (PG8_LAS unsigned char*)lds;
    unsigned char* ws = a.ws; const int G = gridDim.x;
    const int lo = a.ph_lo, hi = a.ph_hi;
#define IN(k) (lo <= (k) && (k) < hi)
#if MK_MULTI
#define SEAM(k) do { } while (0)
#else
#define SEAM(k) do { if (IN(k) && IN((k) + 1)) xcd_barrier(bar); } while (0)
#endif
#if !MK_MULTI
    if (a.ph_hi > 1000) cg::this_grid().sync();
    volatile LAS unsigned* bst = (volatile LAS unsigned*)(lds3 + LDS_BAR_OFF);
    if (threadIdx.x < 16) bst[threadIdx.x] = 0u;
    __syncthreads();
    XcdBarrier bar = xcd_barrier_post((unsigned*)(ws + WS_BAR), bst);
#endif
    if (IN(0)) p0_prologue(a, lds);
    SEAM(0);
    if (IN(1)) { pg8::Gemm g{(const bf16*)(ws + WS_XN), (const bf16*)(ws + WS_WIN), M, NIN, D}; pg8::StaticOrder S; S.init(M, NIN, G, (int)blockIdx.x);
        pg8::EpiIn E{(bf16*)(ws + WS_PROJ), (float*)(ws + WS_G), a.in[5], (const float*)(ws + WS_ROPE)};
        pg8::gemm_phase<pg8::EpiIn, pg8::StaticOrder, true, true>(lds3, g, S, E); }
    SEAM(1);
    if (IN(2)) { swa_phase(a, lds); gla_local_phase(a, lds); }
    SEAM(2);
    if (IN(3)) gla_scan_phase(a);
    SEAM(3);
    if (IN(4)) gla_out_phase(a, lds);
    SEAM(4);
    if (IN(5)) { pg8::Gemm g{(const bf16*)(ws + WS_MIX), (const bf16*)(ws + WS_WO), M, D, D}; pg8::StaticOrder S; S.init(M, D, G, (int)blockIdx.x);
        pg8::EpiRes E{a.in[0], a.out, (bf16*)(ws + WS_XN), (float*)(ws + WS_SSQ2)};
        pg8::gemm_phase<pg8::EpiRes, pg8::StaticOrder, true, true>(lds3, g, S, E); }
    SEAM(5);
    if (IN(6)) { pg8::Gemm g{(const bf16*)(ws + WS_XN), (const bf16*)(ws + WS_W1), M, FF, D}; pg8::StaticOrder S; S.init(M, FF, G, (int)blockIdx.x);
        pg8::EpiFF1 E{(bf16*)(ws + WS_ACT), (const float*)(ws + WS_SSQ2)};
        pg8::gemm_phase<pg8::EpiFF1, pg8::StaticOrder, true, true>(lds3, g, S, E); }
    SEAM(6);
    if (IN(7)) { pg8::Gemm g{(const bf16*)(ws + WS_ACT), (const bf16*)(ws + WS_W2), M, D, FF}; pg8::StaticOrder S; S.init(M, D, G, (int)blockIdx.x);
        pg8::EpiRes E{a.out, a.out, nullptr, (float*)(ws + WS_SSQ3)};
        pg8::gemm_phase<pg8::EpiRes, pg8::StaticOrder, true, true>(lds3, g, S, E); }
    SEAM(7);
    if (IN(8)) final_norm_phase(a);
#undef IN
#undef SEAM
}

extern "C" void kernel_launch(void* const* d_in, const int* in_sizes, int n_in, void* d_out, int out_size, void* d_ws, size_t ws_size, hipStream_t stream) {
    static int grid = 0;
    if (grid == 0) {
        if (n_in != 13 || in_sizes[0] != M * D || out_size != M * D || ws_size < WS_END) { fprintf(stderr, "kernel_launch: unexpected shapes (n_in %d in0 %d out %d ws %zu)\n", n_in, n_in > 0 ? in_sizes[0] : -1, out_size, ws_size); grid = -1; return; }
        int dev = 0, cus = 0, per_cu = 0;
        (void)hipGetDevice(&dev); (void)hipDeviceGetAttribute(&cus, hipDeviceAttributeMultiprocessorCount, dev);
        if (hipFuncSetAttribute((const void*)hybrid_fwd, hipFuncAttributeMaxDynamicSharedMemorySize, LDS_BYTES) != hipSuccess) { fprintf(stderr, "kernel_launch: hipFuncSetAttribute failed\n"); grid = -1; return; }
        if (hipOccupancyMaxActiveBlocksPerMultiprocessor(&per_cu, (const void*)hybrid_fwd, 512, LDS_BYTES) != hipSuccess || per_cu < 1) { fprintf(stderr, "kernel_launch: occupancy query says %d\n", per_cu); per_cu = 1; }
        (void)hipGetLastError();
        grid = cus * 1;
        if (grid <= 0) grid = 256;
    }
    if (grid < 0) return;
    Args a{};
    for (int i = 0; i < 13; ++i) a.in[i] = (const float*)d_in[i];
    a.out = (float*)d_out; a.ws = (unsigned char*)d_ws;
#if MK_MULTI
    for (int ph = 0; ph < 9; ++ph) { a.ph_lo = ph; a.ph_hi = ph + 1; hipLaunchKernelGGL(hybrid_fwd, dim3(grid), dim3(512), LDS_BYTES, stream, a); }
#else
    a.ph_lo = 0; a.ph_hi = 9;
    if (hipMemsetAsync((char*)d_ws + WS_BAR, 0, BAR_BYTES, stream) != hipSuccess) { fprintf(stderr, "kernel_launch: memset of the barrier words failed\n"); return; }
    void* args[] = {&a};
    hipError_t e = hipLaunchCooperativeKernel((const void*)hybrid_fwd, dim3(grid), dim3(512), args, LDS_BYTES, stream);
    if (e != hipSuccess) fprintf(stderr, "cooperative launch failed: %s (grid %d)\n", hipGetErrorString(e), grid);
#endif
}
```

```cpp
#include <hip/hip_runtime.h>
#include <hip/hip_cooperative_groups.h>
#include <cstdio>
#include <cstdint>
namespace cg = cooperative_groups;
namespace pg8 {
#define PG8_LAS __attribute__((address_space(3)))
typedef unsigned short bf16_t;
typedef short bf16x8 __attribute__((ext_vector_type(8)));
typedef float f32x4 __attribute__((ext_vector_type(4)));
typedef unsigned u32x4 __attribute__((ext_vector_type(4)));
constexpr int BM = 256, BK = 64, HALF = 128, HTB = HALF * BK * 2  , STAGE_BYTES = 8 * HTB, NXCD = 8, WGM = 8;

__host__ __device__ __forceinline__ int lds_byte(int r, int c) { const int st = (r >> 4) * 2 + (c >> 5), rr = r & 15, cc = c & 31, ob = rr * 64 + cc * 2; return st * 1024 + (ob ^ (((ob >> 9) & 1) << 5)); }
__host__ __device__ __forceinline__ void stage_rc(int b, int& R, int& C) { const int st = b / 1024, sb = b % 1024, swz = sb ^ (((sb >> 9) & 1) << 5); R = (st >> 1) * 16 + swz / 64; C = (st & 1) * 32 + (swz % 64) / 2; }
__host__ __device__ __forceinline__ int perm32(int rho) { const int n = rho >> 4, i = rho & 15; return 8 * (i >> 2) + 4 * n + (i & 3); }

struct Unit { int pm, pn; };
struct Gemm { const bf16_t* A; const bf16_t* Bt; int M, N, K; };

struct StaticOrder {
    int nM, nN, nwg, G, c;
    __host__ __device__ void init(int M, int N, int G_, int c_) { nM = M / BM; nN = N / BM; nwg = nM * nN; G = G_; c = c_; }
    __host__ __device__ bool next(int i, Unit& u) const {
        const long L = (long)i * G + c; if (L >= nwg) return false;
        int wgid = (int)L; { const int q = nwg / NXCD, r = nwg % NXCD, xcd = wgid % NXCD, off = wgid / NXCD; wgid = (xcd < r ? xcd * (q + 1) : r * (q + 1) + (xcd - r) * q) + off; }
        const int nig = WGM * nN, gid = wgid / nig, fm = gid * WGM, gsz = (nM - fm) < WGM ? (nM - fm) : WGM;
        u.pm = fm + ((wgid % nig) % gsz); u.pn = (wgid % nig) / gsz; return true;
    }
    __device__ __forceinline__ void a_ready(const Unit&) const {}
    __device__ __forceinline__ void done(const Unit&) const {}
};

__device__ __forceinline__ unsigned cvt_pk_bf16(float lo, float hi) { unsigned r; asm volatile("v_cvt_pk_bf16_f32 %0, %1, %2" : "=v"(r) : "v"(lo), "v"(hi)); return r; }
typedef float f32x2 __attribute__((ext_vector_type(2)));
template <class Epi, class Sched, bool ALIGN_EPI = false, bool SP2 = false>
__device__ __forceinline__ void gemm_phase(PG8_LAS unsigned char* lds, const Gemm g, const Sched& S, const Epi& E) {
    const int tid = threadIdx.x, wid = __builtin_amdgcn_readfirstlane(tid >> 6), lane = tid & 63, wr = wid >> 2, wc = wid & 3, fr = lane & 15, fq = lane >> 4;
    const int K = g.K, nt = K / BK;
    unsigned voffA[2], voffB[2];
#pragma unroll
    for (int i = 0; i < 2; ++i) { int R, C; stage_rc(tid * 16 + i * 8192, R, C); const int Rb = Epi::PERM ? ((R & ~31) + perm32(R & 31)) : R;
        voffA[i] = (unsigned)(R * K + C) * 2u; voffB[i] = (unsigned)(Rb * K + C) * 2u; }
    const size_t kstep = (size_t)(BK * 2);
    const size_t hstep = (size_t)HALF * K * 2;
    const size_t tstep = 2 * hstep;
    const unsigned ldsw = (unsigned)wid * 1024u;
    const int aoff = lds_byte(wr * 64 + fr, fq * 8), boff = lds_byte(wc * 32 + fr, fq * 8);
#define PG8_SA(b, h) (((b) * 2 + (h)) * HTB)
#define PG8_SB(b, h) ((4 + (b) * 2 + (h)) * HTB)
#define PG8_STAGE(bufoff, gbase, voff) do { _Pragma("unroll") for (int _i = 0; _i < 2; ++_i) \
        __builtin_amdgcn_global_load_lds((const unsigned*)((const char*)(gbase) + (voff)[_i]), (PG8_LAS unsigned*)(lds + (bufoff) + ldsw + _i * 8192), 16, 0, 0); } while (0)
#define PG8_LDA(dst, b, h) do { _Pragma("unroll") for (int m = 0; m < 4; ++m) _Pragma("unroll") for (int k = 0; k < 2; ++k) dst[m][k] = *(const PG8_LAS bf16x8*)(lds + PG8_SA(b, h) + aoff + m * 2048 + k * 1024); } while (0)
#define PG8_LDB(dst, b, h) do { _Pragma("unroll") for (int n = 0; n < 2; ++n) _Pragma("unroll") for (int k = 0; k < 2; ++k) dst[n][k] = *(const PG8_LAS bf16x8*)(lds + PG8_SB(b, h) + boff + n * 2048 + k * 1024); } while (0)
#define PG8_MMA(ai, bj, At, Bt) do { __builtin_amdgcn_s_setprio(1); _Pragma("unroll") for (int m = 0; m < 4; ++m) _Pragma("unroll") for (int n = 0; n < 2; ++n) _Pragma("unroll") for (int k = 0; k < 2; ++k) \
        acc[ai][bj][m][n] = __builtin_amdgcn_mfma_f32_16x16x32_bf16(Bt[n][k], At[m][k], acc[ai][bj][m][n], 0, 0, 0); __builtin_amdgcn_s_setprio(0); } while (0)
#define PG8_WAIT_V(n) asm volatile("s_waitcnt vmcnt(" #n ")" ::: "memory")
#define PG8_WAIT_L(n) asm volatile("s_waitcnt lgkmcnt(" #n ")" ::: "memory")
#define PG8_BAR __builtin_amdgcn_s_barrier()
#define PG8_SCHED __builtin_amdgcn_sched_barrier(0)
    Unit cur, nxt; int ui = 0;
    if (!S.next(0, cur)) return;
    f32x4 acc[2][2][4][2];
#pragma unroll
    for (int a = 0; a < 2; ++a)
#pragma unroll
        for (int b = 0; b < 2; ++b)
#pragma unroll
            for (int m = 0; m < 4; ++m)
#pragma unroll
                for (int n = 0; n < 2; ++n) acc[a][b][m][n] = (f32x4){0.f, 0.f, 0.f, 0.f};
    bf16x8 At[4][2], B0[2][2], B1[2][2];
    const char* cA = (const char*)g.A + (size_t)cur.pm * tstep; const char* cB = (const char*)g.Bt + (size_t)cur.pn * tstep;
    S.a_ready(cur);
    if constexpr (SP2) {
        PG8_STAGE(PG8_SB(0, 0), cB, voffB); PG8_STAGE(PG8_SB(0, 1), cB + hstep, voffB); PG8_STAGE(PG8_SA(0, 0), cA, voffA); PG8_STAGE(PG8_SA(0, 1), cA + hstep, voffA);
        if (wr == 1) PG8_BAR;
        PG8_WAIT_V(2); PG8_BAR;
        PG8_STAGE(PG8_SB(1, 0), cB + kstep, voffB); PG8_STAGE(PG8_SA(1, 0), cA + kstep, voffA); PG8_STAGE(PG8_SB(1, 1), cB + hstep + kstep, voffB);
        PG8_WAIT_V(6); PG8_BAR;
    } else {
        PG8_STAGE(PG8_SB(0, 0), cB, voffB); PG8_STAGE(PG8_SA(0, 0), cA, voffA); PG8_STAGE(PG8_SB(0, 1), cB + hstep, voffB); PG8_STAGE(PG8_SA(0, 1), cA + hstep, voffA);
        if (wr == 1) PG8_BAR;
        PG8_WAIT_V(4); PG8_BAR;
        PG8_STAGE(PG8_SB(1, 0), cB + kstep, voffB); PG8_STAGE(PG8_SA(1, 0), cA + kstep, voffA); PG8_STAGE(PG8_SB(1, 1), cB + hstep + kstep, voffB);
        PG8_WAIT_V(6); PG8_BAR;
    }
    for (;;) {
        const bool has_next = S.next(ui + 1, nxt);
        const char* nA = has_next ? (const char*)g.A + (size_t)nxt.pm * tstep : cA; const char* nB = has_next ? (const char*)g.Bt + (size_t)nxt.pn * tstep : cB;
        for (int t = 0; t < nt; t += 2) {
            const bool last = (t == nt - 2);
            const char* a1 = cA + (size_t)(t + 1) * kstep;
            const char* a2 = last ? nA : cA + (size_t)(t + 2) * kstep; const char* b2 = last ? nB : cB + (size_t)(t + 2) * kstep;
            const char* a3 = a2 + kstep; const char* b3 = b2 + kstep;
            if (last && has_next) S.a_ready(nxt);
            if constexpr (SP2) {
            PG8_LDB(B0, 0, 0); PG8_LDB(B1, 0, 1); PG8_SCHED; PG8_LDA(At, 0, 0); PG8_STAGE(PG8_SA(1, 1), a1 + hstep, voffA);
            PG8_WAIT_V(8); PG8_WAIT_L(0); PG8_BAR; PG8_MMA(0, 0, At, B0); PG8_MMA(0, 1, At, B1); PG8_BAR; PG8_SCHED;
            PG8_LDA(At, 0, 1); PG8_STAGE(PG8_SB(0, 0), b2, voffB); PG8_STAGE(PG8_SB(0, 1), b2 + hstep, voffB); PG8_STAGE(PG8_SA(0, 0), a2, voffA);
            PG8_WAIT_V(8); PG8_WAIT_L(0); PG8_BAR; PG8_MMA(1, 0, At, B0); PG8_MMA(1, 1, At, B1); PG8_BAR; PG8_SCHED;
            PG8_LDB(B0, 1, 0); PG8_LDB(B1, 1, 1); PG8_SCHED; PG8_LDA(At, 1, 0); PG8_STAGE(PG8_SA(0, 1), a2 + hstep, voffA);
            PG8_WAIT_V(8); PG8_WAIT_L(0); PG8_BAR; PG8_MMA(0, 0, At, B0); PG8_MMA(0, 1, At, B1); PG8_BAR; PG8_SCHED;
            PG8_LDA(At, 1, 1); PG8_STAGE(PG8_SB(1, 0), b3, voffB); PG8_STAGE(PG8_SB(1, 1), b3 + hstep, voffB); PG8_STAGE(PG8_SA(1, 0), a3, voffA);
            PG8_WAIT_V(8); PG8_WAIT_L(0); PG8_BAR; PG8_MMA(1, 0, At, B0); PG8_MMA(1, 1, At, B1); PG8_BAR; PG8_SCHED;
            } else {
            PG8_LDB(B0, 0, 0); PG8_SCHED; PG8_LDA(At, 0, 0); PG8_STAGE(PG8_SA(1, 1), a1 + hstep, voffA);
            PG8_WAIT_L(8); PG8_BAR; PG8_WAIT_L(0); PG8_MMA(0, 0, At, B0); PG8_BAR; PG8_SCHED;
            PG8_LDB(B1, 0, 1); PG8_STAGE(PG8_SB(0, 0), b2, voffB);
            PG8_BAR; PG8_WAIT_L(0); PG8_MMA(0, 1, At, B1); PG8_BAR;
            PG8_LDA(At, 0, 1); PG8_STAGE(PG8_SA(0, 0), a2, voffA);
            PG8_BAR; PG8_WAIT_L(0); PG8_MMA(1, 0, At, B0); PG8_BAR; PG8_SCHED;
            PG8_STAGE(PG8_SB(0, 1), b2 + hstep, voffB);
            PG8_WAIT_V(6); PG8_BAR; PG8_MMA(1, 1, At, B1); PG8_BAR;
            PG8_LDB(B0, 1, 0); PG8_SCHED; PG8_LDA(At, 1, 0); PG8_STAGE(PG8_SA(0, 1), a2 + hstep, voffA);
            PG8_WAIT_L(8); PG8_BAR; PG8_WAIT_L(0); PG8_MMA(0, 0, At, B0); PG8_BAR; PG8_SCHED;
            PG8_LDB(B1, 1, 1); PG8_STAGE(PG8_SB(1, 0), b3, voffB);
            PG8_BAR; PG8_WAIT_L(0); PG8_MMA(0, 1, At, B1); PG8_BAR;
            PG8_LDA(At, 1, 1); PG8_STAGE(PG8_SA(1, 0), a3, voffA);
            PG8_BAR; PG8_WAIT_L(0); PG8_MMA(1, 0, At, B0); PG8_BAR; PG8_SCHED;
            PG8_STAGE(PG8_SB(1, 1), b3 + hstep, voffB);
            PG8_WAIT_V(6); PG8_BAR; PG8_MMA(1, 1, At, B1); PG8_BAR;
            }
        }
        if constexpr (ALIGN_EPI) { if (wr == 0) PG8_BAR; }
        if constexpr (!Epi::AFTER_DRAIN) { E(acc, cur, wr, wc, fr, fq); S.done(cur); }
        if (!has_next) break;
#pragma unroll
        for (int a = 0; a < 2; ++a)
#pragma unroll
            for (int b = 0; b < 2; ++b)
#pragma unroll
                for (int m = 0; m < 4; ++m)
#pragma unroll
                    for (int n = 0; n < 2; ++n) acc[a][b][m][n] = (f32x4){0.f, 0.f, 0.f, 0.f};
        cur = nxt; cA = nA; cB = nB; ++ui;
        if constexpr (ALIGN_EPI) { if (wr == 1) PG8_BAR; }
    }
    PG8_WAIT_V(0);
    if constexpr (!ALIGN_EPI) { if (wr == 0) PG8_BAR; }
    PG8_BAR;
    if constexpr (Epi::AFTER_DRAIN) { E.fused(acc, cur, wr, wc, fr, fq, lds, wid, lane); S.done(cur); }
#undef PG8_SA
#undef PG8_SB
#undef PG8_STAGE
#undef PG8_LDA
#undef PG8_LDB
#undef PG8_MMA
#undef PG8_WAIT_V
#undef PG8_WAIT_L
#undef PG8_BAR
#undef PG8_SCHED
}
}

#ifndef REP_P0
#define REP_P0 1
#endif
#ifndef REP_P1
#define REP_P1 1
#endif
#ifndef REP_P2S
#define REP_P2S 1
#endif
#ifndef REP_P2G
#define REP_P2G 1
#endif
#ifndef REP_P3
#define REP_P3 1
#endif
#ifndef REP_P4
#define REP_P4 1
#endif
#ifndef REP_P6
#define REP_P6 1
#endif
#ifndef MK_MULTI
#define MK_MULTI 0
#endif
constexpr int T = 8192, NBATCH = 2, M = NBATCH * T, D = 1024, FF = 4096, DIN = 2320, NIN = 2560, LDP = 2304, NMETA = 16, PMW = 1040;
constexpr int GQ = 0, GK = 256, GV = 512, GR = 1024, SQ = 1536, SK = 2048, SV = 2176;
constexpr float EPS = 1e-5f, LOG2E = 1.4426950408889634f;
constexpr size_t MiB = 1u << 20;
constexpr size_t WS_SSQ2 = 0, WS_SSQ3 = 65536, WS_PM = 131072, WS_ROPE = 262144;
constexpr size_t WS_WIN = 1 * MiB, WS_WO = 6 * MiB, WS_W1 = 8 * MiB, WS_W2 = 16 * MiB, WS_DC = 24 * MiB;
constexpr size_t WS_XN = 26 * MiB, WS_PROJ = 58 * MiB, WS_G = 130 * MiB, WS_DST = 146 * MiB, WS_ACT = 58 * MiB, WS_ST = 186 * MiB, WS_MIX = 202 * MiB, WS_END = 234 * MiB;
constexpr size_t WS_BAR = 25 * MiB, BAR_BYTES = 16384;
constexpr int LDS_BAR_OFF = 131072, LDS_BYTES = 131072 + 64;

typedef unsigned short bf16;
typedef short bf16x8 __attribute__((ext_vector_type(8)));
typedef float f32x4 __attribute__((ext_vector_type(4)));
typedef unsigned u32x4 __attribute__((ext_vector_type(4)));
typedef unsigned u32x2 __attribute__((ext_vector_type(2)));
using pg8::cvt_pk_bf16;

__device__ __forceinline__ float bf2f(unsigned short b) { return __uint_as_float((unsigned)b << 16); }
__device__ __forceinline__ float fexp(float x) { return __builtin_amdgcn_exp2f(x * LOG2E); }
__device__ __forceinline__ float wave_sum(float v) {
#pragma unroll
    for (int o = 1; o < 64; o <<= 1) v += __shfl_xor(v, o);
    return v;
}
__device__ __forceinline__ float logsig(float v) {
    const float e = __builtin_amdgcn_exp2f(-fabsf(v) * LOG2E);
    return fminf(v, 0.f) - __builtin_amdgcn_logf(1.f + e) * 0.6931471805599453f;
}
__device__ __forceinline__ u32x4 pack8(f32x4 a, f32x4 b) { u32x4 w; w.x = cvt_pk_bf16(a[0], a[1]); w.y = cvt_pk_bf16(a[2], a[3]); w.z = cvt_pk_bf16(b[0], b[1]); w.w = cvt_pk_bf16(b[2], b[3]); return w; }

struct Args { const float* in[13]; float* out; unsigned char* ws; int ph_lo, ph_hi; };
#define XB_TMO      128
#define XB_XCNT(j)  (256  + 64 * (j))
#define XB_XSUB(j)  (1280 + 64 * (j))
#define XB_XGEN(j)  (2304 + 64 * (j))
#define XB_TOP      3328
#define XB_TOPGEN   3392
#define XCD_BAR_WORDS 3456
#define XB_SPIN_CAP (1u << 18)
#define LAS __attribute__((address_space(3)))

__device__ __forceinline__ unsigned xb_ld(unsigned* p)              { return __hip_atomic_load(p, __ATOMIC_RELAXED, __HIP_MEMORY_SCOPE_AGENT); }
__device__ __forceinline__ unsigned xb_add(unsigned* p, unsigned v) { return __hip_atomic_fetch_add(p, v, __ATOMIC_RELAXED, __HIP_MEMORY_SCOPE_AGENT); }
__device__ __forceinline__ unsigned xb_xcc_id() { return (unsigned)__builtin_amdgcn_s_getreg((3 << 11) | 20) & 0xFu; }
#define XB_SPIN(cond, bar) do { unsigned _sp = 0; while (cond) { __builtin_amdgcn_s_sleep(1); \
    if ((++_sp & 255u) == 0u) { if (xb_ld(&(bar)[XB_TMO])) break; if (_sp > XB_SPIN_CAP) { atomicAdd(&(bar)[XB_TMO], 1u); break; } } } } while (0)

struct XcdBarrier {
    unsigned* bar; unsigned x;
    volatile LAS unsigned* st;
};

__device__ __forceinline__ XcdBarrier xcd_barrier_post(unsigned* bar, volatile LAS unsigned* st) {
    XcdBarrier b; b.bar = bar; b.x = xb_xcc_id(); b.st = st;
    if (threadIdx.x == 0) (void)xb_add(&bar[XB_XCNT(b.x)], 1u);
    return b;
}
__device__ __forceinline__ void xcd_barrier_complete(unsigned* bar, unsigned x, unsigned& nloc, unsigned& nx) {
    const unsigned G = gridDim.x * gridDim.y * gridDim.z;
    unsigned sum, cnt, mine, sp = 0u;
    for (;;) {
        sum = 0u; cnt = 0u; mine = 0u;
#pragma unroll
        for (unsigned j = 0; j < 16; ++j) { const unsigned c = xb_ld(&bar[XB_XCNT(j)]); sum += c; cnt += (c > 0u) ? 1u : 0u; mine = (j == x) ? c : mine; }
        if (sum == G) break;
        __builtin_amdgcn_s_sleep(1);
        if ((++sp & 255u) == 0u) { if (xb_ld(&bar[XB_TMO])) break; if (sp > XB_SPIN_CAP) { atomicAdd(&bar[XB_TMO], 1u); break; } }
    }
    nloc = mine > 0u ? mine : 1u; nx = cnt > 0u ? cnt : 1u;
}

__device__ __forceinline__ void xcd_barrier(const XcdBarrier& b) {
    asm volatile("s_waitcnt vmcnt(0)" ::: "memory");
    __syncthreads();
    if (threadIdx.x == 0) {
        unsigned* bar = b.bar;
        __builtin_amdgcn_s_waitcnt(0);
        unsigned nloc = b.st[0], nx = b.st[1];
        if (nloc == 0u) { xcd_barrier_complete(bar, b.x, nloc, nx); b.st[0] = nloc; b.st[1] = nx; }
        const unsigned old = xb_add(&bar[XB_XSUB(b.x)], 1u);
        const unsigned gen = old / nloc;
        if (old + 1u == (gen + 1u) * nloc) {
            __builtin_amdgcn_fence(__ATOMIC_RELEASE, "agent");
            asm volatile("s_waitcnt vmcnt(0)" ::: "memory");
            const unsigned og = xb_add(&bar[XB_TOP], 1u);
            const unsigned tg = og / nx;
            if (og + 1u == (tg + 1u) * nx) xb_add(&bar[XB_TOPGEN], 1u);
            else XB_SPIN(xb_ld(&bar[XB_TOPGEN]) == tg, bar);
            __builtin_amdgcn_fence(__ATOMIC_ACQUIRE, "agent");
            xb_add(&bar[XB_XGEN(b.x)], 1u);
            asm volatile("s_waitcnt vmcnt(0)" ::: "memory");
        } else {
            XB_SPIN(xb_ld(&bar[XB_XGEN(b.x)]) == gen, bar);
            __builtin_amdgcn_fence(__ATOMIC_ACQUIRE, "agent");
            asm volatile("s_waitcnt vmcnt(0)" ::: "memory");
        }
    }
    __syncthreads();
}


namespace pg8 {
struct EpiIn {
    static constexpr bool PERM = true, AFTER_DRAIN = false;
    bf16_t* P; float* G; const float* bgate; const float* rope;
    __device__ __forceinline__ void operator()(const f32x4 (&acc)[2][2][4][2], const Unit& u, int wr, int wc, int fr, int fq) const {
        const int row0 = u.pm * BM + wr * 64 + fr, pn = u.pn;
        if (pn == 9) {
            const int col0 = wc * 32 + 8 * fq;
            f32x4 bv[2][2];
#pragma unroll
            for (int bj = 0; bj < 2; ++bj)
#pragma unroll
                for (int n = 0; n < 2; ++n) bv[bj][n] = *(const f32x4*)(bgate + col0 + bj * HALF + 4 * n);
#pragma unroll
            for (int ai = 0; ai < 2; ++ai)
#pragma unroll
                for (int m = 0; m < 4; ++m) { float* rowp = G + (size_t)(row0 + ai * HALF + m * 16) * 256 + col0;
#pragma unroll
                    for (int bj = 0; bj < 2; ++bj)
#pragma unroll
                        for (int n = 0; n < 2; ++n) { f32x4 v = acc[ai][bj][m][n] + bv[bj][n]; f32x4 g;
#pragma unroll
                            for (int e = 0; e < 4; ++e) g[e] = logsig(v[e]) * 0.0625f;
                            *(f32x4*)(rowp + bj * HALF + 4 * n) = g; } }
        } else {
            const bool rope_tile = (pn >= 6) && ((wc & 1) == 0);
            const float sc = (pn == 0 || pn == 6 || pn == 7) ? 0.125f : 1.f;
            const int col0 = pn * BM + wc * 32 + 8 * fq;
            const float sgn = (fq == 0) ? -1.f : 1.f; const bool app = fq < 2;
#pragma unroll
            for (int ai = 0; ai < 2; ++ai)
#pragma unroll
                for (int m = 0; m < 4; ++m) { const int row = row0 + ai * HALF + m * 16; bf16_t* rowp = P + (size_t)row * 2304 + col0;
                    f32x4 c0 = {1.f, 1.f, 1.f, 1.f}, c1 = c0, s0 = {0.f, 0.f, 0.f, 0.f}, s1 = s0;
                    if (rope_tile) { const float* rp = rope + (size_t)(16 + (row & 8191)) * 16; c0 = *(const f32x4*)rp; c1 = *(const f32x4*)(rp + 4); s0 = *(const f32x4*)(rp + 8); s1 = *(const f32x4*)(rp + 12); }
#pragma unroll
                    for (int bj = 0; bj < 2; ++bj) { f32x4 v0 = acc[ai][bj][m][0], v1 = acc[ai][bj][m][1];
                        if (rope_tile && (pn != 8 || bj == 0)) {
                            f32x4 p0, p1;
#pragma unroll
                            for (int e = 0; e < 4; ++e) { p0[e] = __shfl_xor(v0[e], 16); p1[e] = __shfl_xor(v1[e], 16); }
                            if (app) { v0 = v0 * c0 + (p0 * s0) * sgn; v1 = v1 * c1 + (p1 * s1) * sgn; }
                        }
                        v0 = v0 * sc; v1 = v1 * sc;
                        u32x4 w; w.x = cvt_pk_bf16(v0[0], v0[1]); w.y = cvt_pk_bf16(v0[2], v0[3]); w.z = cvt_pk_bf16(v1[0], v1[1]); w.w = cvt_pk_bf16(v1[2], v1[3]);
                        *(u32x4*)(rowp + bj * HALF) = w; } }
        }
    }
};
struct EpiRes {
    static constexpr bool PERM = true, AFTER_DRAIN = false;
    const float* base; float* out; bf16_t* hb; float* ssq;
    __device__ __forceinline__ void operator()(const f32x4 (&acc)[2][2][4][2], const Unit& u, int wr, int wc, int fr, int fq) const {
        const int row0 = u.pm * BM + wr * 64 + fr, col0 = u.pn * BM + wc * 32 + 8 * fq;
#pragma unroll
        for (int ai = 0; ai < 2; ++ai)
#pragma unroll
            for (int m = 0; m < 4; ++m) { const int row = row0 + ai * HALF + m * 16; const size_t off = (size_t)row * 1024 + col0; float ss = 0.f;
#pragma unroll
                for (int bj = 0; bj < 2; ++bj) { const f32x4 x0 = *(const f32x4*)(base + off + bj * HALF), x1 = *(const f32x4*)(base + off + bj * HALF + 4);
                    const f32x4 h0 = acc[ai][bj][m][0] + x0, h1 = acc[ai][bj][m][1] + x1;
                    *(f32x4*)(out + off + bj * HALF) = h0; *(f32x4*)(out + off + bj * HALF + 4) = h1;
                    if (hb) { u32x4 w; w.x = cvt_pk_bf16(h0[0], h0[1]); w.y = cvt_pk_bf16(h0[2], h0[3]); w.z = cvt_pk_bf16(h1[0], h1[1]); w.w = cvt_pk_bf16(h1[2], h1[3]); *(u32x4*)(hb + off + bj * HALF) = w; }
                    ss += (h0[0] * h0[0] + h0[1] * h0[1]) + (h0[2] * h0[2] + h0[3] * h0[3]) + (h1[0] * h1[0] + h1[1] * h1[1]) + (h1[2] * h1[2] + h1[3] * h1[3]); }
                ss += __shfl_xor(ss, 16); ss += __shfl_xor(ss, 32);
                if (fq == 0) atomicAdd(ssq + row, ss); }
    }
};
struct EpiFF1 {
    static constexpr bool PERM = true, AFTER_DRAIN = false;
    bf16_t* O; const float* ssq;
    __device__ __forceinline__ void operator()(const f32x4 (&acc)[2][2][4][2], const Unit& u, int wr, int wc, int fr, int fq) const {
        const int row0 = u.pm * BM + wr * 64 + fr, col0 = u.pn * BM + wc * 32 + 8 * fq;
#pragma unroll
        for (int ai = 0; ai < 2; ++ai)
#pragma unroll
            for (int m = 0; m < 4; ++m) { const int row = row0 + ai * HALF + m * 16; const float rs = __builtin_amdgcn_rsqf(ssq[row] * (1.f / 1024.f) + 1e-5f);
                bf16_t* rowp = O + (size_t)row * 4096 + col0;
#pragma unroll
                for (int bj = 0; bj < 2; ++bj) { f32x4 v0 = acc[ai][bj][m][0] * rs, v1 = acc[ai][bj][m][1] * rs;
#pragma unroll
                    for (int e = 0; e < 4; ++e) { const float a = fmaxf(v0[e], 0.f), b = fmaxf(v1[e], 0.f); v0[e] = a * a; v1[e] = b * b; }
                    u32x4 w; w.x = cvt_pk_bf16(v0[0], v0[1]); w.y = cvt_pk_bf16(v0[2], v0[3]); w.z = cvt_pk_bf16(v1[0], v1[1]); w.w = cvt_pk_bf16(v1[2], v1[3]);
                    *(u32x4*)(rowp + bj * HALF) = w; } }
    }
};
}

__device__ __forceinline__ void p0_transpose_item(const float* W, int ldw, int K, const float* scale, bf16* WT, int src_col0, int dst_row0, int k0, float* scr, int lane) {
    float v[32];
    const float* wp = W + (size_t)(k0 + (lane >> 5)) * ldw + src_col0 + (lane & 31);
#pragma unroll
    for (int i = 0; i < 32; ++i) v[i] = wp[(size_t)(2 * i) * ldw];
#pragma unroll
    for (int i = 0; i < 32; ++i) scr[(2 * i + (lane >> 5)) * 33 + (lane & 31)] = v[i];
    asm volatile("s_waitcnt lgkmcnt(0)" ::: "memory");
    const int c = lane & 7;
    f32x4 sa = {1.f, 1.f, 1.f, 1.f}, sb = sa;
    if (scale) { sa = *(const f32x4*)(scale + k0 + 8 * c); sb = *(const f32x4*)(scale + k0 + 8 * c + 4); }
#pragma unroll
    for (int j = 0; j < 4; ++j) { const int n = (lane >> 3) + 8 * j; const float* s = scr + (8 * c) * 33 + n;
        u32x4 o; o.x = cvt_pk_bf16(s[0 * 33] * sa[0], s[1 * 33] * sa[1]); o.y = cvt_pk_bf16(s[2 * 33] * sa[2], s[3 * 33] * sa[3]); o.z = cvt_pk_bf16(s[4 * 33] * sb[0], s[5 * 33] * sb[1]); o.w = cvt_pk_bf16(s[6 * 33] * sb[2], s[7 * 33] * sb[3]);
        *(u32x4*)(WT + (size_t)(dst_row0 + n) * K + k0 + 8 * c) = o; }
    asm volatile("s_waitcnt lgkmcnt(0)" ::: "memory");
}

__device__ __forceinline__ void p0_prologue(const Args& a, unsigned char* lds) {
    const int tid = threadIdx.x, lane = tid & 63, wave = tid >> 6, G = gridDim.x, blk = blockIdx.x;
    unsigned char* ws = a.ws;
    const float* x = a.in[0]; const float* nmw = a.in[2]; const float* w_in = a.in[3]; const float* wgu = a.in[4];
    bf16* WIN = (bf16*)(ws + WS_WIN); bf16* XN = (bf16*)(ws + WS_XN);
    const int gtid = blk * 512 + tid, NT = G * 512;
    for (int e = gtid; e < 32768; e += NT) ((float*)(ws + WS_SSQ2))[e] = 0.f;
    for (int e = gtid; e < (T + NMETA) * 8; e += NT) { const int pos = e >> 3, i = e & 7;
        const float inv = exp2f(-(float)i * (18.931568569324174f * 0.125f)); const float ang = (float)pos * inv;
        double r = (double)ang * 0.15915494309189535; r -= floor(r); const float rf = (float)r;
        float* rp = (float*)(ws + WS_ROPE) + (size_t)pos * 16; rp[i] = __builtin_amdgcn_cosf(rf); rp[8 + i] = __builtin_amdgcn_sinf(rf); }
    for (int e = gtid; e < 256 * 128; e += NT) { const int n = e >> 7, k8 = e & 127; float wg[16];
#pragma unroll
        for (int r = 0; r < 16; ++r) wg[r] = wgu[r * 256 + n];
        float o[8];
#pragma unroll
        for (int kk = 0; kk < 8; ++kk) { const int k = 8 * k8 + kk; const f32x4* p = (const f32x4*)(w_in + (size_t)k * DIN + 1536); float s = 0.f;
#pragma unroll
            for (int q = 0; q < 4; ++q) { const f32x4 v = p[q]; s += (v[0] * wg[4 * q] + v[1] * wg[4 * q + 1]) + (v[2] * wg[4 * q + 2] + v[3] * wg[4 * q + 3]); }
            o[kk] = s * nmw[k]; }
        u32x4 w; w.x = cvt_pk_bf16(o[0], o[1]); w.y = cvt_pk_bf16(o[2], o[3]); w.z = cvt_pk_bf16(o[4], o[5]); w.w = cvt_pk_bf16(o[6], o[7]);
        *(u32x4*)(WIN + (size_t)(2304 + n) * D + 8 * k8) = w; }
    float* scr = (float*)lds + wave * 2112;
    const int gw = blk * 8 + wave, NGW = G * 8;
    for (int it = gw; it < 16 * 72; it += NGW) { const int kb = it / 72, nb = it % 72, dr = 32 * nb; p0_transpose_item(w_in, DIN, D, nmw, WIN, dr < 1536 ? dr : dr + 16, dr, 64 * kb, scr, lane); }
    for (int m0 = gw; m0 < M; m0 += 4 * NGW) { f32x4 v[4][4];
#pragma unroll
        for (int q = 0; q < 4; ++q) { const int m = m0 + q * NGW; if (m < M) { const f32x4* xr = (const f32x4*)(x + (size_t)m * D) + lane;
#pragma unroll
                for (int j = 0; j < 4; ++j) v[q][j] = xr[64 * j]; } }
#pragma unroll
        for (int q = 0; q < 4; ++q) { const int m = m0 + q * NGW; if (m < M) { float s = 0.f;
#pragma unroll
                for (int j = 0; j < 4; ++j) s += (v[q][j][0] * v[q][j][0] + v[q][j][1] * v[q][j][1]) + (v[q][j][2] * v[q][j][2] + v[q][j][3] * v[q][j][3]);
                const float rstd = 1.0f / sqrtf(wave_sum(s) * (1.f / D) + EPS);
                u32x2* o8 = (u32x2*)(XN + (size_t)m * D) + lane;
#pragma unroll
                for (int j = 0; j < 4; ++j) { u32x2 w; w.x = cvt_pk_bf16(v[q][j][0] * rstd, v[q][j][1] * rstd); w.y = cvt_pk_bf16(v[q][j][2] * rstd, v[q][j][3] * rstd); o8[64 * j] = w; } } } }
}

__device__ __forceinline__ void p1_tail(const Args& a, unsigned char* lds, int rank, int nr) {
    const int tid = threadIdx.x, lane = tid & 63, wave = tid >> 6;
    unsigned char* ws = a.ws;
    const float* meta = a.in[1]; const float* nmw = a.in[2]; const float* w_in = a.in[3];
    const float* w_out = a.in[8]; const float* nfw = a.in[9]; const float* w1 = a.in[10]; const float* w2 = a.in[11];
    bf16* WO = (bf16*)(ws + WS_WO); bf16* W1 = (bf16*)(ws + WS_W1); bf16* W2 = (bf16*)(ws + WS_W2);
    for (int cb = rank; cb < 65; cb += nr) {
        float* um = (float*)lds; float* red = (float*)(lds + 65536);
        for (int r = 2 * wave; r < 2 * wave + 2; ++r) { const f32x4* xr = (const f32x4*)(meta + (size_t)r * D) + lane; f32x4 v[4]; float s = 0.f;
#pragma unroll
            for (int j = 0; j < 4; ++j) { v[j] = xr[64 * j]; s += (v[j][0] * v[j][0] + v[j][1] * v[j][1]) + (v[j][2] * v[j][2] + v[j][3] * v[j][3]); }
            const float rstd = 1.0f / sqrtf(wave_sum(s) * (1.f / D) + EPS);
#pragma unroll
            for (int j = 0; j < 4; ++j) { const f32x4 w = ((const f32x4*)nmw)[lane + 64 * j]; ((f32x4*)(um + r * D))[lane + 64 * j] = v[j] * rstd * w; } }
        __syncthreads();
        const int col = tid & 15, ks = tid >> 4, j = 16 * cb + col;
        const int src = j < 768 ? 256 + j : (j < 784 ? 1536 + (j - 768) : 2064 + (j - 784));
        float acc[16];
#pragma unroll
        for (int r = 0; r < 16; ++r) acc[r] = 0.f;
        float wv[32];
#pragma unroll
        for (int k = 0; k < 32; ++k) wv[k] = w_in[(size_t)(32 * ks + k) * DIN + src];
#pragma unroll
        for (int k = 0; k < 32; k += 4) {
#pragma unroll
            for (int r = 0; r < 16; ++r) { const f32x4 uv = *(const f32x4*)(um + r * D + 32 * ks + k); acc[r] += (uv[0] * wv[k] + uv[1] * wv[k + 1]) + (uv[2] * wv[k + 2] + uv[3] * wv[k + 3]); } }
#pragma unroll
        for (int r = 0; r < 16; ++r) red[(ks * 16 + r) * 16 + col] = acc[r];
        __syncthreads();
        if (tid < 256) { const int r = tid >> 4, c = tid & 15; float s = 0.f;
#pragma unroll
            for (int k2 = 0; k2 < 32; ++k2) s += red[(k2 * 16 + r) * 16 + c];
            ((float*)(ws + WS_PM))[r * PMW + 16 * cb + c] = s; }
        __syncthreads();
    }
    float* scr = (float*)lds + wave * 2112;
    constexpr int I_O = 16 * 32, I_1 = 16 * 128, I_2 = 64 * 32, NITEMS = I_O + I_1 + I_2;
    for (int it = rank * 8 + wave; it < NITEMS; it += nr * 8) { int r = it;
        if (r < I_O) { const int kb = r / 32, nb = r % 32; p0_transpose_item(w_out, D, D, nullptr, WO, 32 * nb, 32 * nb, 64 * kb, scr, lane); continue; } r -= I_O;
        if (r < I_1) { const int kb = r / 128, nb = r % 128; p0_transpose_item(w1, FF, D, nfw, W1, 32 * nb, 32 * nb, 64 * kb, scr, lane); continue; } r -= I_1;
        { const int kb = r / 32, nb = r % 32; p0_transpose_item(w2, D, FF, nullptr, W2, 32 * nb, 32 * nb, 64 * kb, scr, lane); } }
}

__device__ __forceinline__ void swa_phase(const Args& a, unsigned char* lds) {
    const int tid = threadIdx.x, lane = tid & 63, w = tid >> 6, fr = lane & 15, fq = lane >> 4;
    unsigned char* ws = a.ws;
    const bf16* P = (const bf16*)(ws + WS_PROJ); const float* PM = (const float*)(ws + WS_PM); const float* rope = (const float*)(ws + WS_ROPE);
    bf16* MIX = (bf16*)(ws + WS_MIX); const float* sinks = a.in[7];
    bf16* KS = (bf16*)lds;
    bf16* VT = (bf16*)(lds + 39168);
    for (int unit = blockIdx.x; unit < 256; unit += gridDim.x) {
        const int b = unit >> 7, n = (unit >> 1) & 63, kv = unit & 1;
        const size_t tok0 = (size_t)b * T + 128 * n;
        const int gh = w >> 1, th = w & 1, qh = 4 * kv + gh; const float sink2 = sinks[qh] * LOG2E;
        const bf16* qbase = P + (tok0 + 64 * th + fr) * LDP + SQ + 64 * qh + 8 * fq;
        bf16x8 qn0 = *(const bf16x8*)(qbase), qn1 = *(const bf16x8*)(qbase + 32);
#pragma unroll
        for (int i = 0; i < 4; ++i) { const int c = tid + 512 * i, jj = c >> 3, dc = c & 7; u32x4 v = {0u, 0u, 0u, 0u};
            if (n > 0 || jj >= 128) v = *(const u32x4*)(P + ((long)tok0 - 128 + jj) * LDP + SK + 64 * kv + 8 * dc);
            *(u32x4*)(KS + (16 + jj) * 72 + 8 * dc) = v; }
        if (tid < 128) { const int t = tid >> 3, dc = tid & 7; const float* src = PM + t * PMW + 784 + 64 * kv;
            f32x4 x0 = *(const f32x4*)(src + 8 * dc), x1 = *(const f32x4*)(src + 8 * dc + 4);
            if (dc < 2) { const f32x4 p0 = *(const f32x4*)(src + 8 * (1 - dc)), p1 = *(const f32x4*)(src + 8 * (1 - dc) + 4); const float* rp = rope + t * 16;
                const f32x4 c0 = *(const f32x4*)rp, c1 = *(const f32x4*)(rp + 4), s0 = *(const f32x4*)(rp + 8), s1 = *(const f32x4*)(rp + 12); const float sgn = dc == 0 ? -1.f : 1.f;
                x0 = x0 * c0 + (p0 * s0) * sgn; x1 = x1 * c1 + (p1 * s1) * sgn; }
            *(u32x4*)(KS + t * 72 + 8 * dc) = pack8(x0, x1);
        } else if (tid < 256) { const int d = tid & 63, hf = (tid >> 6) & 1; const float* src = PM + (8 * hf) * PMW + 912 + 64 * kv + d; float v[8];
#pragma unroll
            for (int i = 0; i < 8; ++i) v[i] = src[i * PMW];
            u32x4 wv; wv.x = cvt_pk_bf16(v[0], v[1]); wv.y = cvt_pk_bf16(v[2], v[3]); wv.z = cvt_pk_bf16(v[4], v[5]); wv.w = cvt_pk_bf16(v[6], v[7]);
            *(u32x4*)(VT + d * 280 + 8 * hf) = wv; }
        { const int d = tid & 63, sg = tid >> 6; unsigned short vr[32];
            const bool ok = (n > 0 || sg >= 4); const bf16* vp = P + ((long)tok0 - 128 + 32 * sg) * LDP + SV + 64 * kv + d;
#pragma unroll
            for (int i = 0; i < 32; ++i) vr[i] = ok ? vp[(long)i * LDP] : (unsigned short)0;
#pragma unroll
            for (int q = 0; q < 4; ++q) { u32x4 wv; wv.x = vr[8 * q] | ((unsigned)vr[8 * q + 1] << 16); wv.y = vr[8 * q + 2] | ((unsigned)vr[8 * q + 3] << 16); wv.z = vr[8 * q + 4] | ((unsigned)vr[8 * q + 5] << 16); wv.w = vr[8 * q + 6] | ((unsigned)vr[8 * q + 7] << 16);
                *(u32x4*)(VT + d * 280 + 16 + 32 * sg + 8 * q) = wv; } }
        __syncthreads();
#pragma unroll 1
        for (int it = 0; it < 4; ++it) {
            const int r0 = 64 * th + 16 * it; const size_t qrow = tok0 + r0 + fr;
            bf16x8 qf[2]; qf[0] = qn0; qf[1] = qn1;
            if (it < 3) { qn0 = *(const bf16x8*)(qbase + (size_t)(16 * (it + 1)) * LDP); qn1 = *(const bf16x8*)(qbase + (size_t)(16 * (it + 1)) * LDP + 32); }
            f32x4 s[10];
#pragma unroll
            for (int tl = 0; tl < 10; ++tl) { const int krow0 = tl == 0 ? 0 : 16 + r0 + 16 * (tl - 1); f32x4 acc = {0.f, 0.f, 0.f, 0.f};
#pragma unroll
                for (int kk = 0; kk < 2; ++kk) { const bf16x8 kf = *(const bf16x8*)(KS + (krow0 + fr) * 72 + 32 * kk + 8 * fq); acc = __builtin_amdgcn_mfma_f32_16x16x32_bf16(kf, qf[kk], acc, 0, 0, 0); }
                s[tl] = acc; }
            float mx = sink2; const int rr = r0 + fr;
#pragma unroll
            for (int tl = 0; tl < 10; ++tl)
#pragma unroll
                for (int e = 0; e < 4; ++e) { float v = s[tl][e] * LOG2E;
                    if (tl > 0) { const int jj = r0 + 16 * (tl - 1) + 4 * fq + e, dist = 128 + rr - jj; const bool ok = dist >= 0 && dist < 128 && (n > 0 || jj >= 128); v = ok ? v : -INFINITY; }
                    s[tl][e] = v; mx = fmaxf(mx, v); }
            mx = fmaxf(mx, __shfl_xor(mx, 16)); mx = fmaxf(mx, __shfl_xor(mx, 32));
            float l = 0.f;
#pragma unroll
            for (int tl = 0; tl < 10; ++tl)
#pragma unroll
                for (int e = 0; e < 4; ++e) { const float p = __builtin_amdgcn_exp2f(s[tl][e] - mx); s[tl][e] = p; l += p; }
            l += __shfl_xor(l, 16); l += __shfl_xor(l, 32); l += __builtin_amdgcn_exp2f(sink2 - mx);
            const float rl = 1.0f / l;
            f32x4 o[4];
#pragma unroll
            for (int dt = 0; dt < 4; ++dt) o[dt] = (f32x4){0.f, 0.f, 0.f, 0.f};
#pragma unroll
            for (int pr = 0; pr < 5; ++pr) { const int ta = 2 * pr, tb = 2 * pr + 1;
                const int ka = ta == 0 ? 0 : 16 + r0 + 16 * (ta - 1), kb = 16 + r0 + 16 * (tb - 1);
                const u32x4 pw = pack8(s[ta], s[tb]); const bf16x8 pf = __builtin_bit_cast(bf16x8, pw);
#pragma unroll
                for (int dt = 0; dt < 4; ++dt) { const bf16* vrow = VT + (16 * dt + fr) * 280 + 4 * fq;
                    const u32x2 va = *(const u32x2*)(vrow + ka), vb = *(const u32x2*)(vrow + kb); const u32x4 vw = {va.x, va.y, vb.x, vb.y};
                    o[dt] = __builtin_amdgcn_mfma_f32_16x16x32_bf16(__builtin_bit_cast(bf16x8, vw), pf, o[dt], 0, 0, 0); } }
#pragma unroll
            for (int dt = 0; dt < 4; ++dt) { u32x2 wv; wv.x = cvt_pk_bf16(o[dt][0] * rl, o[dt][1] * rl); wv.y = cvt_pk_bf16(o[dt][2] * rl, o[dt][3] * rl);
                *(u32x2*)(MIX + qrow * D + 512 + 64 * qh + 16 * dt + 4 * fq) = wv; }
        }
        __syncthreads();
    }
}

__device__ __forceinline__ void gla_local_phase(const Args& a, unsigned char* lds) {
    const int tid = threadIdx.x, hb = tid >> 8, t256 = tid & 255, lane = tid & 63, w4 = (tid >> 6) & 3, fr = lane & 15, fq = lane >> 4;
    unsigned char* ws = a.ws;
    const bf16* P = (const bf16*)(ws + WS_PROJ); const float* G = (const float*)(ws + WS_G); float* DST = (float*)(ws + WS_DST); float* DC = (float*)(ws + WS_DC);
    unsigned char* base = lds + hb * 28672;
    bf16* KT = (bf16*)base; bf16* VT = (bf16*)(base + 9216); float* tot = (float*)(base + 27648);
    for (int p = blockIdx.x; p < 512; p += gridDim.x) {
        const int v = 2 * p + hb, h = v & 3, c = (v >> 2) & 127, b = v >> 9; const size_t row0 = (size_t)b * T + 64 * c; const int uidx = (b * 4 + h) * 128 + c;
        const int i = t256 & 63, seg = t256 >> 6;
        float bc[16];
        { const float* gp = G + (row0 + 16 * seg) * 256 + 64 * h + i; float run = 0.f;
#pragma unroll
            for (int tt = 0; tt < 16; ++tt) { run += gp[tt * 256]; bc[tt] = run; } }
        tot[seg * 64 + i] = bc[15];
        unsigned short kr[16];
        { const bf16* kp = P + (row0 + 16 * seg) * LDP + GK + 64 * h + i;
#pragma unroll
            for (int tt = 0; tt < 16; ++tt) kr[tt] = kp[(size_t)tt * LDP]; }
        const int j = t256 & 127, sg = t256 >> 7; unsigned short vr[32];
        { const bf16* vp = P + (row0 + 32 * sg) * LDP + GV + 128 * h + j;
#pragma unroll
            for (int tt = 0; tt < 32; ++tt) vr[tt] = vp[(size_t)tt * LDP]; }
        __syncthreads();
        float off = 0.f, total = 0.f;
#pragma unroll
        for (int s = 0; s < 4; ++s) { const float xv = tot[s * 64 + i]; total += xv; if (s < seg) off += xv; }
        float kt[16];
#pragma unroll
        for (int tt = 0; tt < 16; ++tt) kt[tt] = bf2f(kr[tt]) * fexp(total - (bc[tt] + off));
        { u32x4 w0, w1; w0.x = cvt_pk_bf16(kt[0], kt[1]); w0.y = cvt_pk_bf16(kt[2], kt[3]); w0.z = cvt_pk_bf16(kt[4], kt[5]); w0.w = cvt_pk_bf16(kt[6], kt[7]);
            w1.x = cvt_pk_bf16(kt[8], kt[9]); w1.y = cvt_pk_bf16(kt[10], kt[11]); w1.z = cvt_pk_bf16(kt[12], kt[13]); w1.w = cvt_pk_bf16(kt[14], kt[15]);
            *(u32x4*)(KT + i * 72 + 16 * seg) = w0; *(u32x4*)(KT + i * 72 + 16 * seg + 8) = w1; }
        if (seg == 3) DC[uidx * 64 + i] = fexp(total);
#pragma unroll
        for (int q = 0; q < 4; ++q) { u32x4 wv; wv.x = vr[8 * q] | ((unsigned)vr[8 * q + 1] << 16); wv.y = vr[8 * q + 2] | ((unsigned)vr[8 * q + 3] << 16); wv.z = vr[8 * q + 4] | ((unsigned)vr[8 * q + 5] << 16); wv.w = vr[8 * q + 6] | ((unsigned)vr[8 * q + 7] << 16);
            *(u32x4*)(VT + j * 72 + 32 * sg + 8 * q) = wv; }
        __syncthreads();
        f32x4 acc[8];
#pragma unroll
        for (int jt = 0; jt < 8; ++jt) acc[jt] = (f32x4){0.f, 0.f, 0.f, 0.f};
#pragma unroll
        for (int kk = 0; kk < 2; ++kk) { const bf16x8 af = *(const bf16x8*)(KT + (16 * w4 + fr) * 72 + 32 * kk + 8 * fq);
#pragma unroll
            for (int jt = 0; jt < 8; ++jt) { const bf16x8 bfr = *(const bf16x8*)(VT + (16 * jt + fr) * 72 + 32 * kk + 8 * fq); acc[jt] = __builtin_amdgcn_mfma_f32_16x16x32_bf16(af, bfr, acc[jt], 0, 0, 0); } }
        float* dst = DST + (size_t)uidx * 8192;
#pragma unroll
        for (int jt = 0; jt < 8; ++jt) *(f32x4*)(dst + (16 * jt + fr) * 64 + 16 * w4 + 4 * fq) = acc[jt];
        __syncthreads();
    }
}

__device__ __forceinline__ void gla_scan_phase(const Args& a) {
    const int tid = threadIdx.x; if (tid >= 256) return;
    unsigned char* ws = a.ws;
    const float* PM = (const float*)(ws + WS_PM); const float* DST = (const float*)(ws + WS_DST); const float* DC = (const float*)(ws + WS_DC); bf16* ST = (bf16*)(ws + WS_ST);
    const float* wgu = a.in[4]; const float* bgate = a.in[5];
    for (int ge = blockIdx.x * 256 + tid; ge < 65536; ge += gridDim.x * 256) {
        const int bh = ge >> 13, e = ge & 8191, i = e & 63, j = e >> 6, h = bh & 3;
        float S = 0.f;
        { float bc[16]; float run = 0.f; const int gi = 64 * h + i; const float bg = bgate[gi]; float wg[16];
#pragma unroll
            for (int r = 0; r < 16; ++r) wg[r] = wgu[r * 256 + gi];
#pragma unroll
            for (int t = 0; t < 16; ++t) { float lg = bg;
#pragma unroll
                for (int r = 0; r < 16; ++r) lg += PM[t * PMW + 768 + r] * wg[r];
                run += logsig(lg) * 0.0625f; bc[t] = run; }
#pragma unroll
            for (int t = 0; t < 16; ++t) S += PM[t * PMW + gi] * fexp(run - bc[t]) * PM[t * PMW + 256 + 128 * h + j]; }
        const size_t ub = (size_t)bh * 128;
        for (int c0 = 0; c0 < 128; c0 += 8) { float ds[8], dc[8];
#pragma unroll
            for (int q = 0; q < 8; ++q) { ds[q] = DST[(ub + c0 + q) * 8192 + e]; dc[q] = DC[(ub + c0 + q) * 64 + i]; }
#pragma unroll
            for (int q = 0; q < 8; ++q) { ST[(ub + c0 + q) * 8192 + e] = (bf16)(cvt_pk_bf16(S, 0.f) & 0xffffu); S = dc[q] * S + ds[q]; } }
    }
}

__device__ __forceinline__ void gla_out_phase(const Args& a, unsigned char* lds) {
    const int tid = threadIdx.x, hb = tid >> 8, t256 = tid & 255, lane = tid & 63, w4 = (tid >> 6) & 3, fr = lane & 15, fq = lane >> 4;
    unsigned char* ws = a.ws;
    const bf16* P = (const bf16*)(ws + WS_PROJ); const float* G = (const float*)(ws + WS_G); const bf16* ST = (const bf16*)(ws + WS_ST); bf16* MIX = (bf16*)(ws + WS_MIX);
    const float* gnw = a.in[6];
    unsigned char* base = lds + hb * 47104;
    bf16* QS = (bf16*)base; bf16* KS = (bf16*)(base + 9216); bf16* VT = (bf16*)(base + 18432); bf16* AS = (bf16*)(base + 36864); float* tot = (float*)(base + 46080);
    for (int p = blockIdx.x; p < 512; p += gridDim.x) {
        const int v = 2 * p + hb, h = v & 3, c = (v >> 2) & 127, b = v >> 9; const size_t row0 = (size_t)b * T + 64 * c; const int uidx = (b * 4 + h) * 128 + c;
        bf16x8 sf[8][2];
        { const bf16* su = ST + (size_t)uidx * 8192;
#pragma unroll
            for (int jt = 0; jt < 8; ++jt)
#pragma unroll
                for (int kk = 0; kk < 2; ++kk) sf[jt][kk] = *(const bf16x8*)(su + (16 * jt + fr) * 64 + 32 * kk + 8 * fq); }
        const int i = t256 & 63, seg = t256 >> 6;
        float bc[16];
        { const float* gp = G + (row0 + 16 * seg) * 256 + 64 * h + i; float run = 0.f;
#pragma unroll
            for (int tt = 0; tt < 16; ++tt) { run += gp[tt * 256]; bc[tt] = run; } }
        tot[seg * 64 + i] = bc[15];
        unsigned short qr[16], kr[16];
        { const bf16* qp = P + (row0 + 16 * seg) * LDP + GQ + 64 * h + i;
#pragma unroll
            for (int tt = 0; tt < 16; ++tt) { qr[tt] = qp[(size_t)tt * LDP]; kr[tt] = qp[(size_t)tt * LDP + (GK - GQ)]; } }
        const int j = t256 & 127, sg = t256 >> 7; unsigned short vr[32];
        { const bf16* vp = P + (row0 + 32 * sg) * LDP + GV + 128 * h + j;
#pragma unroll
            for (int tt = 0; tt < 32; ++tt) vr[tt] = vp[(size_t)tt * LDP]; }
        unsigned short rgv[8][4];
#pragma unroll
        for (int jt = 0; jt < 8; ++jt)
#pragma unroll
            for (int r = 0; r < 4; ++r) rgv[jt][r] = P[(row0 + 16 * w4 + 4 * fq + r) * LDP + GR + 128 * h + 16 * jt + fr];
        __syncthreads();
        float off = 0.f;
#pragma unroll
        for (int s = 0; s < 3; ++s) { const float xv = tot[s * 64 + i]; if (s < seg) off += xv; }
#pragma unroll
        for (int tt = 0; tt < 16; ++tt) { const float bb = bc[tt] + off; const float qv = bf2f(qr[tt]) * fexp(bb), kv = bf2f(kr[tt]) * fexp(-bb);
            const unsigned w = cvt_pk_bf16(qv, kv); QS[(16 * seg + tt) * 72 + i] = (bf16)(w & 0xffffu); KS[(16 * seg + tt) * 72 + i] = (bf16)(w >> 16); }
#pragma unroll
        for (int q = 0; q < 4; ++q) { u32x4 wv; wv.x = vr[8 * q] | ((unsigned)vr[8 * q + 1] << 16); wv.y = vr[8 * q + 2] | ((unsigned)vr[8 * q + 3] << 16); wv.z = vr[8 * q + 4] | ((unsigned)vr[8 * q + 5] << 16); wv.w = vr[8 * q + 6] | ((unsigned)vr[8 * q + 7] << 16);
            *(u32x4*)(VT + j * 72 + 32 * sg + 8 * q) = wv; }
        __syncthreads();
        bf16x8 qa[2];
#pragma unroll
        for (int kk = 0; kk < 2; ++kk) qa[kk] = *(const bf16x8*)(QS + (16 * w4 + fr) * 72 + 32 * kk + 8 * fq);
#pragma unroll
        for (int st = 0; st < 4; ++st) { f32x4 acc = {0.f, 0.f, 0.f, 0.f};
#pragma unroll
            for (int kk = 0; kk < 2; ++kk) { const bf16x8 kb = *(const bf16x8*)(KS + (16 * st + fr) * 72 + 32 * kk + 8 * fq); acc = __builtin_amdgcn_mfma_f32_16x16x32_bf16(qa[kk], kb, acc, 0, 0, 0); }
#pragma unroll
            for (int r = 0; r < 4; ++r) { const int t = 16 * w4 + 4 * fq + r, s = 16 * st + fr; const float val = s <= t ? acc[r] : 0.f; AS[t * 72 + s] = (bf16)(cvt_pk_bf16(val, 0.f) & 0xffffu); } }
        __syncthreads();
        f32x4 o[8];
#pragma unroll
        for (int jt = 0; jt < 8; ++jt) o[jt] = (f32x4){0.f, 0.f, 0.f, 0.f};
#pragma unroll
        for (int kk = 0; kk < 2; ++kk) { const bf16x8 a1 = *(const bf16x8*)(AS + (16 * w4 + fr) * 72 + 32 * kk + 8 * fq);
#pragma unroll
            for (int jt = 0; jt < 8; ++jt) { const bf16x8 vb = *(const bf16x8*)(VT + (16 * jt + fr) * 72 + 32 * kk + 8 * fq);
                o[jt] = __builtin_amdgcn_mfma_f32_16x16x32_bf16(a1, vb, o[jt], 0, 0, 0); o[jt] = __builtin_amdgcn_mfma_f32_16x16x32_bf16(qa[kk], sf[jt][kk], o[jt], 0, 0, 0); } }
        float rs[4];
#pragma unroll
        for (int r = 0; r < 4; ++r) { float ss = 0.f;
#pragma unroll
            for (int jt = 0; jt < 8; ++jt) ss += o[jt][r] * o[jt][r];
            ss += __shfl_xor(ss, 1); ss += __shfl_xor(ss, 2); ss += __shfl_xor(ss, 4); ss += __shfl_xor(ss, 8);
            rs[r] = 1.0f / sqrtf(ss * (1.f / 128.f) + EPS); }
#pragma unroll
        for (int jt = 0; jt < 8; ++jt) { const int jc = 16 * jt + fr; const float gw_ = gnw[jc];
#pragma unroll
            for (int r = 0; r < 4; ++r) { const size_t row = row0 + 16 * w4 + 4 * fq + r; const float rg = bf2f(rgv[jt][r]);
                const float sl = rg / (1.f + fexp(-rg)); const float val = o[jt][r] * rs[r] * gw_ * sl;
                MIX[row * D + 128 * h + jc] = (bf16)(cvt_pk_bf16(val, 0.f) & 0xffffu); } }
        __syncthreads();
    }
}

__device__ __forceinline__ void final_norm_phase(const Args& a) {
    const int tid = threadIdx.x, lane = tid & 63, wave = tid >> 6; const float* ssq = (const float*)(a.ws + WS_SSQ3); const float* fw = a.in[12];
    f32x4 w[4];
#pragma unroll
    for (int j = 0; j < 4; ++j) w[j] = ((const f32x4*)fw)[lane + 64 * j];
    for (int m = blockIdx.x * 8 + wave; m < M; m += gridDim.x * 8) { f32x4* xr = (f32x4*)(a.out + (size_t)m * D) + lane; const float rstd = 1.0f / sqrtf(ssq[m] * (1.f / D) + EPS);
#pragma unroll
        for (int j = 0; j < 4; ++j) xr[64 * j] = xr[64 * j] * rstd * w[j]; }
}

__global__ void __launch_bounds__(512, 2) hybrid_fwd(Args a) {
    extern __shared__ __attribute__((aligned(16))) unsigned char lds[];
    PG8_LAS unsigned char* lds3 = (PG8_LAS unsigned char*)lds;
    unsigned char* ws = a.ws; const int G = gridDim.x;
    const int lo = a.ph_lo, hi = a.ph_hi;
#define IN(k) (lo <= (k) && (k) < hi)
#if MK_MULTI
#define SEAM(k) do { } while (0)
#else
#define SEAM(k) do { if (IN(k) && IN((k) + 1)) xcd_barrier(bar); } while (0)
#endif
#if !MK_MULTI
    if (a.ph_hi > 1000) cg::this_grid().sync();
    volatile LAS unsigned* bst = (volatile LAS unsigned*)(lds3 + LDS_BAR_OFF);
    if (threadIdx.x < 16) bst[threadIdx.x] = 0u;
    __syncthreads();
    XcdBarrier bar = xcd_barrier_post((unsigned*)(ws + WS_BAR), bst);
#endif
    if (IN(0)) for (int rep = 0; rep < REP_P0; ++rep) { p0_prologue(a, lds); __syncthreads(); }
    SEAM(0);
    if (IN(1)) for (int rep = 0; rep < REP_P1; ++rep) { pg8::Gemm g{(const bf16*)(ws + WS_XN), (const bf16*)(ws + WS_WIN), M, NIN, D}; pg8::StaticOrder S; S.init(M, NIN, G, (int)blockIdx.x);
        pg8::EpiIn E{(bf16*)(ws + WS_PROJ), (float*)(ws + WS_G), a.in[5], (const float*)(ws + WS_ROPE)};
        pg8::gemm_phase<pg8::EpiIn, pg8::StaticOrder, true, true>(lds3, g, S, E);
        { const int first = G / 2; if ((int)blockIdx.x >= first) p1_tail(a, lds, (int)blockIdx.x - first, G - first); } }
    SEAM(1);
    if (IN(2)) { for (int rep = 0; rep < REP_P2S; ++rep) swa_phase(a, lds); for (int rep = 0; rep < REP_P2G; ++rep) gla_local_phase(a, lds); }
    SEAM(2);
    if (IN(3)) for (int rep = 0; rep < REP_P3; ++rep) gla_scan_phase(a);
    SEAM(3);
    if (IN(4)) for (int rep = 0; rep < REP_P4; ++rep) gla_out_phase(a, lds);
    SEAM(4);
    if (IN(5)) { pg8::Gemm g{(const bf16*)(ws + WS_MIX), (const bf16*)(ws + WS_WO), M, D, D}; pg8::StaticOrder S; S.init(M, D, G, (int)blockIdx.x);
        pg8::EpiRes E{a.in[0], a.out, (bf16*)(ws + WS_XN), (float*)(ws + WS_SSQ2)};
        pg8::gemm_phase<pg8::EpiRes, pg8::StaticOrder, true, true>(lds3, g, S, E); }
    SEAM(5);
    if (IN(6)) for (int rep = 0; rep < REP_P6; ++rep) { pg8::Gemm g{(const bf16*)(ws + WS_XN), (const bf16*)(ws + WS_W1), M, FF, D}; pg8::StaticOrder S; S.init(M, FF, G, (int)blockIdx.x);
        pg8::EpiFF1 E{(bf16*)(ws + WS_ACT), (const float*)(ws + WS_SSQ2)};
        pg8::gemm_phase<pg8::EpiFF1, pg8::StaticOrder, true, true>(lds3, g, S, E); }
    SEAM(6);
    if (IN(7)) { pg8::Gemm g{(const bf16*)(ws + WS_ACT), (const bf16*)(ws + WS_W2), M, D, FF}; pg8::StaticOrder S; S.init(M, D, G, (int)blockIdx.x);
        pg8::EpiRes E{a.out, a.out, nullptr, (float*)(ws + WS_SSQ3)};
        pg8::gemm_phase<pg8::EpiRes, pg8::StaticOrder, true, true>(lds3, g, S, E); }
    SEAM(7);
    if (IN(8)) final_norm_phase(a);
#undef IN
#undef SEAM
}

extern "C" void kernel_launch(void* const* d_in, const int* in_sizes, int n_in, void* d_out, int out_size, void* d_ws, size_t ws_size, hipStream_t stream) {
    static int grid = 0;
    if (grid == 0) {
        if (n_in != 13 || in_sizes[0] != M * D || out_size != M * D || ws_size < WS_END) { fprintf(stderr, "kernel_launch: unexpected shapes (n_in %d in0 %d out %d ws %zu)\n", n_in, n_in > 0 ? in_sizes[0] : -1, out_size, ws_size); grid = -1; return; }
        int dev = 0, cus = 0, per_cu = 0;
        (void)hipGetDevice(&dev); (void)hipDeviceGetAttribute(&cus, hipDeviceAttributeMultiprocessorCount, dev);
        if (hipFuncSetAttribute((const void*)hybrid_fwd, hipFuncAttributeMaxDynamicSharedMemorySize, LDS_BYTES) != hipSuccess) { fprintf(stderr, "kernel_launch: hipFuncSetAttribute failed\n"); grid = -1; return; }
        if (hipOccupancyMaxActiveBlocksPerMultiprocessor(&per_cu, (const void*)hybrid_fwd, 512, LDS_BYTES) != hipSuccess || per_cu < 1) { fprintf(stderr, "kernel_launch: occupancy query says %d\n", per_cu); per_cu = 1; }
        (void)hipGetLastError();
        grid = cus * 1;
        if (grid <= 0) grid = 256;
    }
    if (grid < 0) return;
    Args a{};
    for (int i = 0; i < 13; ++i) a.in[i] = (const float*)d_in[i];
    a.out = (float*)d_out; a.ws = (unsigned char*)d_ws;
#if MK_MULTI
    for (int ph = 0; ph < 9; ++ph) { a.ph_lo = ph; a.ph_hi = ph + 1; hipLaunchKernelGGL(hybrid_fwd, dim3(grid), dim3(512), LDS_BYTES, stream, a); }
#else
    a.ph_lo = 0; a.ph_hi = 9;
    if (hipMemsetAsync((char*)d_ws + WS_BAR, 0, BAR_BYTES, stream) != hipSuccess) { fprintf(stderr, "kernel_launch: memset of the barrier words failed\n"); return; }
    void* args[] = {&a};
    hipError_t e = hipLaunchCooperativeKernel((const void*)hybrid_fwd, dim3(grid), dim3(512), args, LDS_BYTES, stream);
    if (e != hipSuccess) fprintf(stderr, "cooperative launch failed: %s (grid %d)\n", hipGetErrorString(e), grid);
#endif
}
```
